# Optimizing an MI355X kernel written in HIP

```python
import jax, jax.numpy as jnp
from jax import lax
import numpy as np

D_MODEL = 1024
BATCH = 8
SEQ = 2048
DEPTH = 1

GRID_W = 64
CTX_LEN = 256
M_HEADS = 8
M_HEAD_DIM = D_MODEL // M_HEADS
M_WIDTH = M_HEADS * M_HEAD_DIM
CHUNK = 128
SC_WIDTH = D_MODEL
FF_HIDDEN = ((8 * D_MODEL // 3 + 127) // 128) * 128
EPS = 1e-6
M_INIT = -1e30
N_GATES = 4 * M_HEADS

OFF_Q = 0
OFF_K = M_WIDTH
OFF_V = 2 * M_WIDTH
OFF_G = 3 * M_WIDTH
OFF_O = OFF_G + N_GATES
OFF_SB = OFF_O + M_WIDTH
OFF_SC = OFF_SB + SC_WIDTH
OFF_SX = OFF_SC + SC_WIDTH
OFF_MG = OFF_SX + SC_WIDTH
IN_COLS = OFF_MG + 2 * D_MODEL
CTX_COLS = OFF_O

kernel_name = "hybrid_mlstm_shortconv_convffn_prefix_block"


def _rmsnorm(x, g):
    x32 = x.astype(jnp.float32)
    y = x32 * lax.rsqrt(jnp.mean(x32 * x32, axis=-1, keepdims=True) + EPS) * g.astype(jnp.float32)
    return y.astype(x.dtype)


def _modulate(x, g, shift, scale):
    return _rmsnorm(x, g) * (1 + scale) + shift


def _conv1d_w3(x, w, b):
    xp = jnp.pad(x, ((0, 0), (1, 1), (0, 0)))
    return xp[:, :-2] * w[0] + xp[:, 1:-1] * w[1] + xp[:, 2:] * w[2] + b


def _conv2d_3x3(x, w, b, rows):
    bsz, t, ch = x.shape
    xg = x.reshape(bsz, rows, GRID_W, ch)
    y = lax.conv_general_dilated(xg, w[:, :, None, :], (1, 1), 'SAME',
                                 dimension_numbers=('NHWC', 'HWIO', 'NHWC'),
                                 feature_group_count=ch)
    return y.reshape(bsz, t, ch) + b


def _mlstm_chunk_scan(q, k, v, ig, lf, state, emit):
    bsz, nh, t, dh = q.shape
    nc = t // CHUNK

    def chunks(a):
        return jnp.moveaxis(a.reshape(bsz, nh, nc, CHUNK, *a.shape[3:]), 2, 0)

    lower_tri = jnp.tril(jnp.ones((CHUNK, CHUNK), dtype=bool))

    def step(carry, inp):
        c_mat, n_vec, m = carry
        qc, kc, vc, ic, fc = inp
        b = jnp.cumsum(fc, axis=-1)
        dmat = b[..., :, None] - b[..., None, :] + ic[..., None, :]
        dmat = jnp.where(lower_tri, dmat, -jnp.inf)
        inter = b + m[..., None]
        m_t = jnp.maximum(inter, jnp.max(dmat, axis=-1))
        w = jnp.exp(dmat - m_t[..., None])
        a_inter = jnp.exp(inter - m_t)
        s = jnp.einsum('bhtd,bhsd->bhts', qc, kc) * w
        num = (a_inter[..., None] * jnp.einsum('bhed,bhtd->bhte', c_mat, qc)
               + jnp.einsum('bhts,bhse->bhte', s, vc))
        den = a_inter * jnp.einsum('bhd,bhtd->bht', n_vec, qc) + jnp.sum(s, axis=-1)
        h = num / jnp.maximum(jnp.abs(den), jnp.exp(-m_t))[..., None]
        b_end = b[..., -1]
        g = b_end[..., None] - b + ic
        m_new = jnp.maximum(b_end + m, jnp.max(g, axis=-1))
        decay = jnp.exp(b_end + m - m_new)
        wk = jnp.exp(g - m_new[..., None])
        c_new = decay[..., None, None] * c_mat + jnp.einsum('bhs,bhse,bhsd->bhed', wk, vc, kc)
        n_new = decay[..., None] * n_vec + jnp.einsum('bhs,bhsd->bhd', wk, kc)
        return (c_new, n_new, m_new), (h if emit else None)

    final, hs = lax.scan(step, state, tuple(chunks(a) for a in (q, k, v, ig, lf)))
    if not emit:
        return final, None
    return final, jnp.moveaxis(hs, 0, 2).reshape(bsz, nh, t, dh)


def _mlstm_prep(p, qk_w, qk_b, g_b):
    bsz, t, _ = p.shape
    qk = jax.nn.silu(_conv1d_w3(p[..., OFF_Q:OFF_V], qk_w, qk_b))

    def heads(a):
        return a.reshape(bsz, t, M_HEADS, M_HEAD_DIM).transpose(0, 2, 1, 3).astype(jnp.float32)

    q = heads(qk[..., :M_WIDTH])
    k = heads(qk[..., M_WIDTH:]) * (M_HEAD_DIM ** -0.5)
    v = heads(p[..., OFF_V:OFF_G])
    g = (p[..., OFF_G:OFF_O] + g_b).astype(jnp.float32).reshape(bsz, t, 4, M_HEADS).transpose(2, 0, 3, 1)
    ig = (g[0], g[2])
    lf = (jax.nn.log_sigmoid(g[1]), jax.nn.log_sigmoid(g[3]))
    return q, k, v, ig, lf


def _mlstm_bidirectional(ctx_parts, lat_parts, emit_ctx):
    qc, kc, vc, igc, lfc = ctx_parts
    ql, kl, vl, igl, lfl = lat_parts
    bsz, nh, _, dh = ql.shape
    h_lat = None
    h_ctx = None
    for d, flip in enumerate((False, True)):
        fl = (lambda a: jnp.flip(a, axis=2)) if flip else (lambda a: a)
        state0 = (jnp.zeros((bsz, nh, dh, dh), jnp.float32),
                  jnp.zeros((bsz, nh, dh), jnp.float32),
                  jnp.full((bsz, nh), M_INIT, jnp.float32))
        st_ctx, hc = _mlstm_chunk_scan(fl(qc), fl(kc), fl(vc), fl(igc[d]), fl(lfc[d]), state0, emit_ctx)
        _, hl = _mlstm_chunk_scan(fl(ql), fl(kl), fl(vl), fl(igl[d]), fl(lfl[d]), st_ctx, True)
        h_lat = fl(hl) if h_lat is None else h_lat + fl(hl)
        if emit_ctx:
            h_ctx = fl(hc) if h_ctx is None else h_ctx + fl(hc)
    return h_lat, h_ctx


def _mlstm_out(h, p, norm_g, w_out):
    bsz, nh, t, dh = h.shape
    h = h * lax.rsqrt(jnp.mean(h * h, axis=-1, keepdims=True) + EPS) \
        * norm_g.astype(jnp.float32).reshape(M_HEADS, 1, M_HEAD_DIM)
    h = h.transpose(0, 2, 1, 3).reshape(bsz, t, M_WIDTH).astype(p.dtype)
    return (h * jax.nn.sigmoid(p[..., OFF_O:OFF_SB])) @ w_out


def _shortconv_branch(p, w, b, w_out):
    bg = p[..., OFF_SB:OFF_SC]
    cg = p[..., OFF_SC:OFF_SX]
    xin = p[..., OFF_SX:OFF_MG]
    return (bg * _conv1d_w3(cg * xin, w, b)) @ w_out


def _merge(p, y_m, y_c, w_o):
    gm = jax.nn.sigmoid(p[..., OFF_MG:OFF_MG + D_MODEL])
    gc = jax.nn.sigmoid(p[..., OFF_MG + D_MODEL:IN_COLS])
    return (gm * y_m + gc * y_c) @ w_o


def _conv_ffn(h, w_up, conv_w, conv_b, w_down, rows):
    u = h @ w_up
    a, g = u[..., :FF_HIDDEN], u[..., FF_HIDDEN:]
    if rows is None:
        a = _conv1d_w3(a, conv_w[1], conv_b)
    else:
        a = _conv2d_3x3(a, conv_w, conv_b, rows)
    return (jax.nn.gelu(a, approximate=True) * g) @ w_down


def setup_inputs(seed: int = 0) -> dict:
    key = jax.random.key(seed)
    ks = jax.random.split(key, 24)
    f32 = jnp.float32

    def nrm(k, shape, s):
        return jax.random.normal(k, shape, f32) * s

    L = DEPTH
    fb = jnp.linspace(3.0, 6.0, M_HEADS, dtype=f32)
    gk = jax.random.split(ks[11], 4)
    gate_b = jnp.concatenate([nrm(gk[0], (L, M_HEADS), 0.1),
                              fb + nrm(gk[1], (L, M_HEADS), 0.1),
                              nrm(gk[2], (L, M_HEADS), 0.1),
                              fb + nrm(gk[3], (L, M_HEADS), 0.1)], axis=-1)
    return {
        "x": nrm(ks[0], (BATCH, SEQ, D_MODEL), 1.0),
        "c": nrm(ks[1], (BATCH, D_MODEL), 1.0),
        "ctx": nrm(ks[2], (BATCH, CTX_LEN, D_MODEL), 1.0),
        "c_ctx": nrm(ks[3], (D_MODEL,), 1.0),
        "ada_w": nrm(ks[4], (L, D_MODEL, 6 * D_MODEL), 0.5 * D_MODEL ** -0.5),
        "ada_b": nrm(ks[5], (L, 6 * D_MODEL), 0.01),
        "norm1_g": 1.0 + nrm(ks[6], (L, D_MODEL), 0.02),
        "norm2_g": 1.0 + nrm(ks[7], (L, D_MODEL), 0.02),
        "w_in": nrm(ks[8], (L, D_MODEL, IN_COLS), D_MODEL ** -0.5),
        "qk_conv_w": nrm(ks[9], (L, 3, 2 * M_WIDTH), 3 ** -0.5),
        "qk_conv_b": nrm(ks[10], (L, 2 * M_WIDTH), 0.01),
        "gate_b": gate_b,
        "mnorm_g": 1.0 + nrm(ks[12], (L, M_WIDTH), 0.02),
        "w_m_out": nrm(ks[13], (L, M_WIDTH, D_MODEL), M_WIDTH ** -0.5),
        "sc_conv_w": nrm(ks[14], (L, 3, SC_WIDTH), 3 ** -0.5),
        "sc_conv_b": nrm(ks[15], (L, SC_WIDTH), 0.01),
        "w_c_out": nrm(ks[16], (L, SC_WIDTH, D_MODEL), SC_WIDTH ** -0.5),
        "w_o": nrm(ks[17], (L, D_MODEL, D_MODEL), D_MODEL ** -0.5),
        "w_up": nrm(ks[18], (L, D_MODEL, 2 * FF_HIDDEN), D_MODEL ** -0.5),
        "ff_conv_w": nrm(ks[19], (L, 3, 3, FF_HIDDEN), 1.0 / 3.0),
        "ff_conv_b": nrm(ks[20], (L, FF_HIDDEN), 0.01),
        "w_down": nrm(ks[21], (L, FF_HIDDEN, D_MODEL), FF_HIDDEN ** -0.5),
        "final_g": 1.0 + nrm(ks[22], (D_MODEL,), 0.02),
    }


def reference(x, c, ctx, c_ctx, ada_w, ada_b, norm1_g, norm2_g, w_in, qk_conv_w, qk_conv_b,
              gate_b, mnorm_g, w_m_out, sc_conv_w, sc_conv_b, w_c_out, w_o, w_up,
              ff_conv_w, ff_conv_b, w_down, final_g):
    rows = x.shape[1] // GRID_W
    for l in range(DEPTH):
        last = l == DEPTH - 1
        mod_x = (jax.nn.silu(c) @ ada_w[l] + ada_b[l]).reshape(-1, 6, D_MODEL)[:, :, None, :]
        mod_c = (jax.nn.silu(c_ctx) @ ada_w[l] + ada_b[l]).reshape(6, D_MODEL)

        hx = _modulate(x, norm1_g[l], mod_x[:, 0], mod_x[:, 1])
        hc = _modulate(ctx, norm1_g[l], mod_c[0], mod_c[1])
        px = hx @ w_in[l]
        pc = hc @ (w_in[l][:, :CTX_COLS] if last else w_in[l])

        lat_parts = _mlstm_prep(px, qk_conv_w[l], qk_conv_b[l], gate_b[l])
        ctx_parts = _mlstm_prep(pc, qk_conv_w[l], qk_conv_b[l], gate_b[l])
        h_lat, h_ctx = _mlstm_bidirectional(ctx_parts, lat_parts, not last)

        y_x = _merge(px,
                     _mlstm_out(h_lat, px, mnorm_g[l], w_m_out[l]),
                     _shortconv_branch(px, sc_conv_w[l], sc_conv_b[l], w_c_out[l]),
                     w_o[l])
        x = x + mod_x[:, 2] * y_x
        if not last:
            y_c = _merge(pc,
                         _mlstm_out(h_ctx, pc, mnorm_g[l], w_m_out[l]),
                         _shortconv_branch(pc, sc_conv_w[l], sc_conv_b[l], w_c_out[l]),
                         w_o[l])
            ctx = ctx + mod_c[2] * y_c

        hx = _modulate(x, norm2_g[l], mod_x[:, 3], mod_x[:, 4])
        x = x + mod_x[:, 5] * _conv_ffn(hx, w_up[l], ff_conv_w[l], ff_conv_b[l], w_down[l], rows)
        if not last:
            hc = _modulate(ctx, norm2_g[l], mod_c[3], mod_c[4])
            ctx = ctx + mod_c[5] * _conv_ffn(hc, w_up[l], ff_conv_w[l], ff_conv_b[l], w_down[l], None)

    return _rmsnorm(x, final_g)
```

```cpp
#include <hip/hip_runtime.h>
#include <hip/hip_cooperative_groups.h>
#include <cstdio>
#include <cstdint>
namespace cg = cooperative_groups;
__device__ __forceinline__ int otid() { int t = (int)threadIdx.x; asm volatile("" : "+v"(t)); return t; }
namespace pg8 {
#define PG8_LAS __attribute__((address_space(3)))
typedef unsigned short bf16_t;
typedef short bf16x8 __attribute__((ext_vector_type(8)));
typedef float f32x4 __attribute__((ext_vector_type(4)));
typedef unsigned u32x4 __attribute__((ext_vector_type(4)));
constexpr int BM = 256, BK = 64, HALF = 128, HTB = HALF * BK * 2, STAGE_BYTES = 8 * HTB, NXCD = 8, WGM = 8;
__host__ __device__ __forceinline__ int lds_byte(int r, int c) { const int st = (r >> 4) * 2 + (c >> 5), rr = r & 15, cc = c & 31, ob = rr * 64 + cc * 2; return st * 1024 + (ob ^ (((ob >> 9) & 1) << 5)); }
__host__ __device__ __forceinline__ void stage_rc(int b, int& R, int& C) { const int st = b / 1024, sb = b % 1024, swz = sb ^ (((sb >> 9) & 1) << 5); R = (st >> 1) * 16 + swz / 64; C = (st & 1) * 32 + (swz % 64) / 2; }
__host__ __device__ __forceinline__ int perm32(int rho) { const int n = rho >> 4, i = rho & 15; return 8 * (i >> 2) + 4 * n + (i & 3); }
struct Unit { int pm, pn; };
struct Gemm { const bf16_t* A; const bf16_t* Bt; int M, N, K; };
struct StaticOrder {
    int nM, nN, nwg, G, c;
    __host__ __device__ void init(int M, int N, int G_, int c_) { nM = M / BM; nN = N / BM; nwg = nM * nN; G = G_; c = c_; }
    __host__ __device__ bool next(int i, Unit& u) const {
        const long L = (long)i * G + c; if (L >= nwg) return false;
        int wgid = (int)L; { const int q = nwg / NXCD, r = nwg % NXCD, xcd = wgid % NXCD, off = wgid / NXCD; wgid = (xcd < r ? xcd * (q + 1) : r * (q + 1) + (xcd - r) * q) + off; }
        const int nig = WGM * nN, gid = wgid / nig, fm = gid * WGM, gsz = (nM - fm) < WGM ? (nM - fm) : WGM;
        u.pm = fm + ((wgid % nig) % gsz); u.pn = (wgid % nig) / gsz; return true;
    }
    __device__ __forceinline__ void a_ready(const Unit&) const {}
    __device__ __forceinline__ void done(const Unit&) const {}
};
template <class Epi, class Sched, bool ALIGN_EPI = false, bool SP2 = false>
__device__ __forceinline__ void gemm_phase(PG8_LAS unsigned char* lds, const Gemm g, const Sched& S, const Epi& E) {
    const int tid = otid(), wid = __builtin_amdgcn_readfirstlane(tid >> 6), lane = tid & 63, wr = wid >> 2, wc = wid & 3, fr = lane & 15, fq = lane >> 4;
    const int K = g.K, nt = K / BK;
    unsigned voffA[2], voffB[2];
#pragma unroll
    for (int i = 0; i < 2; ++i) { int R, C; stage_rc(tid * 16 + i * 8192, R, C); const int Rb = Epi::PERM ? ((R & ~31) + perm32(R & 31)) : R;
        voffA[i] = (unsigned)(R * K + C) * 2u; voffB[i] = (unsigned)(Rb * K + C) * 2u; }
    const size_t kstep = (size_t)(BK * 2);
    const size_t hstep = (size_t)HALF * K * 2;
    const size_t tstep = 2 * hstep;
    const unsigned ldsw = (unsigned)wid * 1024u;
    const int aoff = lds_byte(wr * 64 + fr, fq * 8), boff = lds_byte(wc * 32 + fr, fq * 8);
#define PG8_SA(b, h) (((b) * 2 + (h)) * HTB)
#define PG8_SB(b, h) ((4 + (b) * 2 + (h)) * HTB)
#define PG8_STAGE(bufoff, gbase, voff) do { _Pragma("unroll") for (int _i = 0; _i < 2; ++_i) \
        __builtin_amdgcn_global_load_lds((const unsigned*)((const char*)(gbase) + (voff)[_i]), (PG8_LAS unsigned*)(lds + (bufoff) + ldsw + _i * 8192), 16, 0, 0); } while (0)
#define PG8_LDA(dst, b, h) do { _Pragma("unroll") for (int m = 0; m < 4; ++m) _Pragma("unroll") for (int k = 0; k < 2; ++k) dst[m][k] = *(const PG8_LAS bf16x8*)(lds + PG8_SA(b, h) + aoff + m * 2048 + k * 1024); } while (0)
#define PG8_LDB(dst, b, h) do { _Pragma("unroll") for (int n = 0; n < 2; ++n) _Pragma("unroll") for (int k = 0; k < 2; ++k) dst[n][k] = *(const PG8_LAS bf16x8*)(lds + PG8_SB(b, h) + boff + n * 2048 + k * 1024); } while (0)
#define PG8_MMA(ai, bj, At, Bt) do { __builtin_amdgcn_s_setprio(1); _Pragma("unroll") for (int m = 0; m < 4; ++m) _Pragma("unroll") for (int n = 0; n < 2; ++n) _Pragma("unroll") for (int k = 0; k < 2; ++k) \
        acc[ai][bj][m][n] = __builtin_amdgcn_mfma_f32_16x16x32_bf16(Bt[n][k], At[m][k], acc[ai][bj][m][n], 0, 0, 0); __builtin_amdgcn_s_setprio(0); } while (0)
#define PG8_WAIT_V(n) asm volatile("s_waitcnt vmcnt(" #n ")" ::: "memory")
#define PG8_WAIT_L(n) asm volatile("s_waitcnt lgkmcnt(" #n ")" ::: "memory")
#define PG8_BAR __builtin_amdgcn_s_barrier()
#define PG8_SCHED __builtin_amdgcn_sched_barrier(0)
    Unit cur, nxt; int ui = 0;
    if (!S.next(0, cur)) return;
    f32x4 acc[2][2][4][2];
#pragma unroll
    for (int a = 0; a < 2; ++a)
#pragma unroll
        for (int b = 0; b < 2; ++b)
#pragma unroll
            for (int m = 0; m < 4; ++m)
#pragma unroll
                for (int n = 0; n < 2; ++n) acc[a][b][m][n] = (f32x4){0.f, 0.f, 0.f, 0.f};
    bf16x8 At[4][2], B0[2][2], B1[2][2];
    const char* cA = (const char*)g.A + (size_t)cur.pm * tstep; const char* cB = (const char*)g.Bt + (size_t)cur.pn * tstep;
    S.a_ready(cur);
    if constexpr (SP2) {
        PG8_STAGE(PG8_SB(0, 0), cB, voffB); PG8_STAGE(PG8_SB(0, 1), cB + hstep, voffB); PG8_STAGE(PG8_SA(0, 0), cA, voffA); PG8_STAGE(PG8_SA(0, 1), cA + hstep, voffA);
        if (wr == 1) PG8_BAR;
        PG8_WAIT_V(2); PG8_BAR;
        PG8_STAGE(PG8_SB(1, 0), cB + kstep, voffB); PG8_STAGE(PG8_SA(1, 0), cA + kstep, voffA); PG8_STAGE(PG8_SB(1, 1), cB + hstep + kstep, voffB);
        PG8_WAIT_V(6); PG8_BAR;
    } else {
        PG8_STAGE(PG8_SB(0, 0), cB, voffB); PG8_STAGE(PG8_SA(0, 0), cA, voffA); PG8_STAGE(PG8_SB(0, 1), cB + hstep, voffB); PG8_STAGE(PG8_SA(0, 1), cA + hstep, voffA);
        if (wr == 1) PG8_BAR;
        PG8_WAIT_V(4); PG8_BAR;
        PG8_STAGE(PG8_SB(1, 0), cB + kstep, voffB); PG8_STAGE(PG8_SA(1, 0), cA + kstep, voffA); PG8_STAGE(PG8_SB(1, 1), cB + hstep + kstep, voffB);
        PG8_WAIT_V(6); PG8_BAR;
    }
    for (;;) {
        const bool has_next = S.next(ui + 1, nxt);
        const char* nA = has_next ? (const char*)g.A + (size_t)nxt.pm * tstep : cA; const char* nB = has_next ? (const char*)g.Bt + (size_t)nxt.pn * tstep : cB;
        for (int t = 0; t < nt; t += 2) {
            const bool last = (t == nt - 2);
            const char* a1 = cA + (size_t)(t + 1) * kstep;
            const char* a2 = last ? nA : cA + (size_t)(t + 2) * kstep; const char* b2 = last ? nB : cB + (size_t)(t + 2) * kstep;
            const char* a3 = a2 + kstep; const char* b3 = b2 + kstep;
            if constexpr (Epi::MIDK) { if (t == (nt >> 1)) E.mid(acc, cur, wr, wc, fr, fq); }
            if (last && has_next) S.a_ready(nxt);
            if constexpr (SP2) {
            PG8_LDB(B0, 0, 0); PG8_LDB(B1, 0, 1); PG8_SCHED; PG8_LDA(At, 0, 0); PG8_STAGE(PG8_SA(1, 1), a1 + hstep, voffA);
            PG8_WAIT_V(8); PG8_WAIT_L(0); PG8_BAR; PG8_MMA(0, 0, At, B0); PG8_MMA(0, 1, At, B1); PG8_BAR; PG8_SCHED;
            PG8_LDA(At, 0, 1); PG8_STAGE(PG8_SB(0, 0), b2, voffB); PG8_STAGE(PG8_SB(0, 1), b2 + hstep, voffB); PG8_STAGE(PG8_SA(0, 0), a2, voffA);
            PG8_WAIT_V(8); PG8_WAIT_L(0); PG8_BAR; PG8_MMA(1, 0, At, B0); PG8_MMA(1, 1, At, B1); PG8_BAR; PG8_SCHED;
            PG8_LDB(B0, 1, 0); PG8_LDB(B1, 1, 1); PG8_SCHED; PG8_LDA(At, 1, 0); PG8_STAGE(PG8_SA(0, 1), a2 + hstep, voffA);
            PG8_WAIT_V(8); PG8_WAIT_L(0); PG8_BAR; PG8_MMA(0, 0, At, B0); PG8_MMA(0, 1, At, B1); PG8_BAR; PG8_SCHED;
            PG8_LDA(At, 1, 1); PG8_STAGE(PG8_SB(1, 0), b3, voffB); PG8_STAGE(PG8_SB(1, 1), b3 + hstep, voffB); PG8_STAGE(PG8_SA(1, 0), a3, voffA);
            PG8_WAIT_V(8); PG8_WAIT_L(0); PG8_BAR; PG8_MMA(1, 0, At, B0); PG8_MMA(1, 1, At, B1); PG8_BAR; PG8_SCHED;
            } else {
            PG8_LDB(B0, 0, 0); PG8_SCHED; PG8_LDA(At, 0, 0); PG8_STAGE(PG8_SA(1, 1), a1 + hstep, voffA);
            PG8_WAIT_L(8); PG8_BAR; PG8_WAIT_L(0); PG8_MMA(0, 0, At, B0); PG8_BAR; PG8_SCHED;
            PG8_LDB(B1, 0, 1); PG8_STAGE(PG8_SB(0, 0), b2, voffB);
            PG8_BAR; PG8_WAIT_L(0); PG8_MMA(0, 1, At, B1); PG8_BAR;
            PG8_LDA(At, 0, 1); PG8_STAGE(PG8_SA(0, 0), a2, voffA);
            PG8_BAR; PG8_WAIT_L(0); PG8_MMA(1, 0, At, B0); PG8_BAR; PG8_SCHED;
            PG8_STAGE(PG8_SB(0, 1), b2 + hstep, voffB);
            PG8_WAIT_V(6); PG8_BAR; PG8_MMA(1, 1, At, B1); PG8_BAR;
            PG8_LDB(B0, 1, 0); PG8_SCHED; PG8_LDA(At, 1, 0); PG8_STAGE(PG8_SA(0, 1), a2 + hstep, voffA);
            PG8_WAIT_L(8); PG8_BAR; PG8_WAIT_L(0); PG8_MMA(0, 0, At, B0); PG8_BAR; PG8_SCHED;
            PG8_LDB(B1, 1, 1); PG8_STAGE(PG8_SB(1, 0), b3, voffB);
            PG8_BAR; PG8_WAIT_L(0); PG8_MMA(0, 1, At, B1); PG8_BAR;
            PG8_LDA(At, 1, 1); PG8_STAGE(PG8_SA(1, 0), a3, voffA);
            PG8_BAR; PG8_WAIT_L(0); PG8_MMA(1, 0, At, B0); PG8_BAR; PG8_SCHED;
            PG8_STAGE(PG8_SB(1, 1), b3 + hstep, voffB);
            PG8_WAIT_V(6); PG8_BAR; PG8_MMA(1, 1, At, B1); PG8_BAR;
            }
        }
        if constexpr (ALIGN_EPI) { if (wr == 0) PG8_BAR; }
        if constexpr (!Epi::AFTER_DRAIN) { E(acc, cur, wr, wc, fr, fq); S.done(cur); }
        if (!has_next) break;
#pragma unroll
        for (int a = 0; a < 2; ++a)
#pragma unroll
            for (int b = 0; b < 2; ++b)
#pragma unroll
                for (int m = 0; m < 4; ++m)
#pragma unroll
                    for (int n = 0; n < 2; ++n) acc[a][b][m][n] = (f32x4){0.f, 0.f, 0.f, 0.f};
        cur = nxt; cA = nA; cB = nB; ++ui;
        if constexpr (ALIGN_EPI) { if (wr == 1) PG8_BAR; }
    }
    PG8_WAIT_V(0);
    if constexpr (!ALIGN_EPI) { if (wr == 0) PG8_BAR; }
    PG8_BAR;
    if constexpr (Epi::AFTER_DRAIN) { E.fused(acc, cur, wr, wc, fr, fq, lds, wid, lane); S.done(cur); }
#undef PG8_SA
#undef PG8_SB
#undef PG8_STAGE
#undef PG8_LDA
#undef PG8_LDB
#undef PG8_MMA
#undef PG8_WAIT_V
#undef PG8_WAIT_L
#undef PG8_BAR
#undef PG8_SCHED
}
}

#define LAS __attribute__((address_space(3)))
typedef unsigned short bf16_t;
typedef short bf16x8 __attribute__((ext_vector_type(8)));
typedef short bf16x4 __attribute__((ext_vector_type(4)));
typedef float f32x4 __attribute__((ext_vector_type(4)));
typedef unsigned u32x4 __attribute__((ext_vector_type(4)));
typedef unsigned u32x2 __attribute__((ext_vector_type(2)));

constexpr int NT = 512;
constexpr int D = 1024, TOKL = 16384, TOKC = 2048, TOK = TOKL + TOKC, SEQ = 2048, CTXL = 256, FF = 2816;
constexpr int IN_COLS = 9248;
constexpr int N1A = 3328, N1B = 6144;
constexpr float EPS = 1e-6f;
constexpr size_t KiB = 1024, MiB = 1024 * 1024;
constexpr size_t OFF_WIN = 0, OFF_WM = 18 * MiB + 512 * KiB, OFF_WC = OFF_WM + 2 * MiB, OFF_WO = OFF_WC + 2 * MiB, OFF_WUP = OFF_WO + 2 * MiB,
                 OFF_WDN = OFF_WUP + 11 * MiB, OFF_MOD = 41 * MiB, OFF_GATES = 41 * MiB + 512 * KiB,
                 OFF_AH = 44 * MiB, OFF_QKV = 80 * MiB, SZ_TOK = (size_t)TOK * D * 2  , OFF_V = OFF_QKV + 2 * SZ_TOK, OFF_K = 188 * MiB,
                 OFF_HF = 80 * MiB, OFF_HB = 112 * MiB, OFF_O = 144 * MiB, OFF_SB = 176 * MiB, OFF_U = 208 * MiB,
                 OFF_T = 80 * MiB, OFF_Z = 44 * MiB, OFF_HX2 = 224 * MiB, OFF_A = 44 * MiB, OFF_G = 132 * MiB, WS_NEED = 256 * MiB;
constexpr int LDS_BYTES = 152 * 1024;
constexpr size_t OFF_HCTR = 41 * MiB + 256 * KiB + 32 * KiB;

struct Params {
    const float *x, *c, *ctx, *c_ctx, *ada_w, *ada_b, *norm1_g, *norm2_g, *w_in, *qk_conv_w, *qk_conv_b, *gate_b, *mnorm_g, *w_m_out,
                *sc_conv_w, *sc_conv_b, *w_c_out, *w_o, *w_up, *ff_conv_w, *ff_conv_b, *w_down, *final_g;
    float* out; unsigned char* ws;
};

typedef __bf16 bf16v2_t __attribute__((ext_vector_type(2)));
typedef float f32v2_t __attribute__((ext_vector_type(2)));
__device__ __forceinline__ unsigned pk2(float lo, float hi) { const f32v2_t f = {lo, hi}; const bf16v2_t b = __builtin_convertvector(f, bf16v2_t); return __builtin_bit_cast(unsigned, b); }
__device__ __forceinline__ float bflo(unsigned w) { return __uint_as_float(w << 16); }
__device__ __forceinline__ float bfhi(unsigned w) { return __uint_as_float(w & 0xffff0000u); }
__device__ __forceinline__ void unpack8(const u32x4 w, float (&f)[8]) { f[0] = bflo(w.x); f[1] = bfhi(w.x); f[2] = bflo(w.y); f[3] = bfhi(w.y); f[4] = bflo(w.z); f[5] = bfhi(w.z); f[6] = bflo(w.w); f[7] = bfhi(w.w); }
__device__ __forceinline__ u32x4 pack8(const float (&f)[8]) { u32x4 w; w.x = pk2(f[0], f[1]); w.y = pk2(f[2], f[3]); w.z = pk2(f[4], f[5]); w.w = pk2(f[6], f[7]); return w; }
__device__ __forceinline__ float sigmoidf_(float v) { return __builtin_amdgcn_rcpf(1.0f + __expf(-v)); }
__device__ __forceinline__ float wave_sum(float v) {
#pragma unroll
    for (int o = 1; o < 64; o <<= 1) v += __shfl_xor(v, o);
    return v;
}
#define LDS_WAIT() asm volatile("s_waitcnt lgkmcnt(0)" ::: "memory")

__device__ __forceinline__ int win_row(int c) {
    if (c < 3104) return c;
    if (c < 5152) return N1A + (c - 3104);
    if (c < 6176) { const int i = (c - 5152) >> 7, r = (c - 5152) & 127; return N1A + 2048 + i * 256 + r; }
    if (c < 7200) { const int i = (c - 6176) >> 7, r = (c - 6176) & 127; return N1A + 2048 + i * 256 + 128 + r; }
    return N1A + 4096 + (c - 7200);
}
struct TrItem { const float* W; bf16_t* WT; int N, k0, n0, pitch, koff; bool win; };
constexpr int TI_NB_IN = (IN_COLS + 255) / 256, TI_IN = 16 * TI_NB_IN, TI_SQ = 16 * 4, TI_UP = 16 * (2 * FF / 256), TI_DN = (FF / 64) * 4, TI_ALL = TI_IN + 3 * TI_SQ + TI_UP + TI_DN;
__device__ __forceinline__ bool tr_decode(const Params& p, int it, TrItem& t) {
    if (it >= TI_ALL) return false;
    int r = it; t.win = false; t.koff = 0; t.pitch = D;
    if (r < TI_IN) { t.W = p.w_in; t.WT = (bf16_t*)(p.ws + OFF_WIN); t.N = IN_COLS; t.k0 = (r / TI_NB_IN) * 64; t.n0 = (r % TI_NB_IN) * 256; t.win = true; return true; } r -= TI_IN;
    if (r < TI_SQ) { t.W = p.w_m_out; t.WT = (bf16_t*)(p.ws + OFF_WM); t.N = D; t.k0 = (r >> 2) * 64; t.n0 = (r & 3) * 256; t.pitch = 2 * D; return true; } r -= TI_SQ;
    if (r < TI_SQ) { t.W = p.w_c_out; t.WT = (bf16_t*)(p.ws + OFF_WM); t.N = D; t.k0 = (r >> 2) * 64; t.n0 = (r & 3) * 256; t.pitch = 2 * D; t.koff = D; return true; } r -= TI_SQ;
    if (r < TI_SQ) { t.W = p.w_o; t.WT = (bf16_t*)(p.ws + OFF_WO); t.N = D; t.k0 = (r >> 2) * 64; t.n0 = (r & 3) * 256; return true; } r -= TI_SQ;
    if (r < TI_UP) { t.W = p.w_up; t.WT = (bf16_t*)(p.ws + OFF_WUP); t.N = 2 * FF; t.k0 = (r / (2 * FF / 256)) * 64; t.n0 = (r % (2 * FF / 256)) * 256; return true; } r -= TI_UP;
    t.W = p.w_down; t.WT = (bf16_t*)(p.ws + OFF_WDN); t.N = D; t.k0 = (r >> 2) * 64; t.n0 = (r & 3) * 256; t.pitch = FF; return true;
}
__device__ __forceinline__ void tr_load(const TrItem& t, f32x4 (&v)[8], int wave, int lane) {
    const int n = t.n0 + 4 * lane; const bool ok = n < t.N;
    const float* src = t.W + (size_t)(t.k0 + wave) * t.N + n;
#pragma unroll
    for (int i = 0; i < 8; ++i) v[i] = ok ? *(const f32x4*)(src + (size_t)(8 * i) * t.N) : (f32x4){0.f, 0.f, 0.f, 0.f};
}
__device__ __forceinline__ void phase0(const Params& p, LAS unsigned char* lds) {
    const int tid = otid(), lane = tid & 63, wave = tid >> 6;
    LAS float* sc = (LAS float*)lds;
    LAS float* part = (LAS float*)(lds + 8192);
    float* mod = (float*)(p.ws + OFF_MOD);
    for (int item = blockIdx.x; item < 192; item += gridDim.x) {
        const int cg = item % 24, ksl = item / 24;
        for (int i = tid; i < 9 * 128; i += NT) { const int r = i >> 7, k = ksl * 128 + (i & 127); const float v = r < 8 ? p.c[r * 1024 + k] : p.c_ctx[k]; sc[i] = v / (1.0f + __expf(-v)); }
        __syncthreads();
        f32x4 acc[9];
#pragma unroll
        for (int r = 0; r < 9; ++r) acc[r] = (f32x4){0.f, 0.f, 0.f, 0.f};
        const float* src = p.ada_w + (size_t)(ksl * 128 + wave) * 6144 + cg * 256 + 4 * lane;
        f32x4 wv[16];
#pragma unroll
        for (int i = 0; i < 16; ++i) wv[i] = *(const f32x4*)(src + (size_t)(8 * i) * 6144);
#pragma unroll
        for (int i = 0; i < 16; ++i) {
#pragma unroll
            for (int r = 0; r < 9; ++r) acc[r] += wv[i] * sc[r * 128 + wave + 8 * i]; }
#pragma unroll
        for (int r = 0; r < 9; ++r) *(LAS f32x4*)(part + (wave * 9 + r) * 256 + 4 * lane) = acc[r];
        __syncthreads();
        for (int o = tid; o < 9 * 256; o += NT) { const int r = o >> 8, cc = o & 255; float sum = ksl == 0 ? p.ada_b[cg * 256 + cc] : 0.f;
#pragma unroll
            for (int q = 0; q < 8; ++q) sum += part[(q * 9 + r) * 256 + cc];
            (void)__hip_atomic_fetch_add(mod + r * 6144 + cg * 256 + cc, sum, __ATOMIC_RELAXED, __HIP_MEMORY_SCOPE_AGENT); }
        asm volatile("s_waitcnt vmcnt(0)" ::: "memory");
        __syncthreads();
        if (tid == 0) (void)__hip_atomic_fetch_add((unsigned*)(p.ws + OFF_HCTR), 1u, __ATOMIC_RELAXED, __HIP_MEMORY_SCOPE_AGENT);
    }
    { u32x4* z = (u32x4*)(p.ws + OFF_WIN + (size_t)3104 * D * 2); const int n16 = 224 * D * 2 / 16;
      for (int i = blockIdx.x * NT + tid; i < n16; i += gridDim.x * NT) z[i] = (u32x4){0u, 0u, 0u, 0u}; }
    LAS float* tile = (LAS float*)lds;
    const int G = (int)gridDim.x;
    TrItem cur, nxt; f32x4 v[8];
    int it = G - 1 - (int)blockIdx.x;
    bool have = tr_decode(p, it, cur);
    if (have) tr_load(cur, v, wave, lane);
    while (have) {
#pragma unroll
        for (int i = 0; i < 8; ++i) { LAS float* q = tile + (wave + 8 * i) * 257 + 4 * lane; q[0] = v[i][0]; q[1] = v[i][1]; q[2] = v[i][2]; q[3] = v[i][3]; }
        __syncthreads();
        it += G;
        const bool more = tr_decode(p, it, nxt);
        if (more) tr_load(nxt, v, wave, lane);
#pragma unroll
        for (int j = 0; j < 4; ++j) { const int c = tid + NT * j, n = c >> 3, kc = c & 7, ng = cur.n0 + n;
            if (ng < cur.N) { const LAS float* q = tile + (kc * 8) * 257 + n;
                u32x4 o; o.x = pk2(q[0], q[257]); o.y = pk2(q[2 * 257], q[3 * 257]); o.z = pk2(q[4 * 257], q[5 * 257]); o.w = pk2(q[6 * 257], q[7 * 257]);
                const int drow = cur.win ? win_row(ng & ~31) + (ng & 31) : ng;
                *(u32x4*)(cur.WT + (size_t)drow * cur.pitch + cur.koff + cur.k0 + kc * 8) = o; } }
        __syncthreads();
        cur = nxt; have = more;
    }
}

__device__ __forceinline__ void modnorm_rows4(const float* xrow, const float* g, const float* shift, const float* scale, bf16_t* orow, int lane) {
    f32x4 v[4][4]; float s[4];
#pragma unroll
    for (int r = 0; r < 4; ++r)
#pragma unroll
        for (int j = 0; j < 4; ++j) v[r][j] = ((const f32x4*)(xrow + (size_t)r * D))[lane + 64 * j];
#pragma unroll
    for (int r = 0; r < 4; ++r) { float a = 0.f;
#pragma unroll
        for (int j = 0; j < 4; ++j) a += (v[r][j].x * v[r][j].x + v[r][j].y * v[r][j].y) + (v[r][j].z * v[r][j].z + v[r][j].w * v[r][j].w);
        s[r] = a; }
#pragma unroll
    for (int o = 1; o < 64; o <<= 1) {
#pragma unroll
        for (int r = 0; r < 4; ++r) s[r] += __shfl_xor(s[r], o); }
#pragma unroll
    for (int j = 0; j < 4; ++j) { const int cidx = lane + 64 * j; const f32x4 gg = ((const f32x4*)g)[cidx], sh = ((const f32x4*)shift)[cidx], sc = ((const f32x4*)scale)[cidx]; const f32x4 gs = gg * (sc + 1.0f);
#pragma unroll
        for (int r = 0; r < 4; ++r) { const float rstd = rsqrtf(s[r] * (1.0f / D) + EPS); const f32x4 y = v[r][j] * rstd * gs + sh; u32x2 w; w.x = pk2(y.x, y.y); w.y = pk2(y.z, y.w); ((u32x2*)(orow + (size_t)r * D))[cidx] = w; } }
}
__device__ __forceinline__ void phase1(const Params& p) {
    const int tid_ = otid(), lane = tid_ & 63, gw = blockIdx.x * 8 + (tid_ >> 6), ngw = gridDim.x * 8;
    const float* mod = (const float*)(p.ws + OFF_MOD); bf16_t* ah = (bf16_t*)(p.ws + OFF_AH);
    for (int row = gw * 4; row < TOK; row += ngw * 4) {
        const float* src = row < TOKC ? p.ctx + (size_t)row * D : p.x + (size_t)(row - TOKC) * D;
        const int mi = row < TOKC ? 8 : (row - TOKC) >> 11;
        modnorm_rows4(src, p.norm1_g, mod + mi * 6144, mod + mi * 6144 + 1024, ah + (size_t)row * D, lane);
    }
}
constexpr size_t OFF_BAR = 41 * MiB + 256 * KiB, OFF_RS = OFF_BAR + 64 * KiB, ZERO_BYTES = 192 * KiB;

#define XB_TMO      128
#define XB_XCNT(j)  (256  + 64 * (j))
#define XB_XSUB(j)  (1280 + 64 * (j))
#define XB_XGEN(j)  (2304 + 64 * (j))
#define XB_TOP      3328
#define XB_TOPGEN   3392
#define XCD_BAR_WORDS 3456
#define XB_SPIN_CAP (1u << 18)

__device__ __forceinline__ unsigned xb_ld(unsigned* p)              { return __hip_atomic_load(p, __ATOMIC_RELAXED, __HIP_MEMORY_SCOPE_AGENT); }
__device__ __forceinline__ unsigned xb_add(unsigned* p, unsigned v) { return __hip_atomic_fetch_add(p, v, __ATOMIC_RELAXED, __HIP_MEMORY_SCOPE_AGENT); }
__device__ __forceinline__ unsigned xb_xcc_id() { return (unsigned)__builtin_amdgcn_s_getreg((3 << 11) | 20) & 0xFu; }
#define XB_SPIN(cond, bar) do { unsigned _sp = 0; while (cond) { __builtin_amdgcn_s_sleep(1); \
    if ((++_sp & 255u) == 0u) { if (xb_ld(&(bar)[XB_TMO])) break; if (_sp > XB_SPIN_CAP) { atomicAdd(&(bar)[XB_TMO], 1u); break; } } } } while (0)

struct XcdBarrier {
    unsigned* bar; unsigned x;
    volatile LAS unsigned* st;
};

__device__ __forceinline__ XcdBarrier xcd_barrier_post(unsigned* bar, volatile LAS unsigned* st) {
    XcdBarrier b; b.bar = bar; b.x = xb_xcc_id(); b.st = st;
    if (threadIdx.x == 0) (void)xb_add(&bar[XB_XCNT(b.x)], 1u);
    return b;
}
__device__ __forceinline__ void xcd_barrier_complete(unsigned* bar, unsigned x, unsigned& nloc, unsigned& nx) {
    const unsigned G = gridDim.x * gridDim.y * gridDim.z;
    unsigned sum, cnt, mine, sp = 0u;
    for (;;) {
        sum = 0u; cnt = 0u; mine = 0u;
#pragma unroll
        for (unsigned j = 0; j < 16; ++j) { const unsigned c = xb_ld(&bar[XB_XCNT(j)]); sum += c; cnt += (c > 0u) ? 1u : 0u; mine = (j == x) ? c : mine; }
        if (sum == G) break;
        __builtin_amdgcn_s_sleep(1);
        if ((++sp & 255u) == 0u) { if (xb_ld(&bar[XB_TMO])) break; if (sp > XB_SPIN_CAP) { atomicAdd(&bar[XB_TMO], 1u); break; } }
    }
    nloc = mine > 0u ? mine : 1u; nx = cnt > 0u ? cnt : 1u;
}

__device__ __forceinline__ void xcd_barrier(const XcdBarrier& b) {
    asm volatile("s_waitcnt vmcnt(0)" ::: "memory");
    __syncthreads();
    if (threadIdx.x == 0) {
        unsigned* bar = b.bar;
        __builtin_amdgcn_s_waitcnt(0);
        unsigned nloc = b.st[0], nx = b.st[1];
        if (nloc == 0u) { xcd_barrier_complete(bar, b.x, nloc, nx); b.st[0] = nloc; b.st[1] = nx; }
        const unsigned old = xb_add(&bar[XB_XSUB(b.x)], 1u);
        const unsigned gen = old / nloc;
        if (old + 1u == (gen + 1u) * nloc) {
            __builtin_amdgcn_fence(__ATOMIC_RELEASE, "agent");
            asm volatile("s_waitcnt vmcnt(0)" ::: "memory");
            const unsigned og = xb_add(&bar[XB_TOP], 1u);
            const unsigned tg = og / nx;
            if (og + 1u == (tg + 1u) * nx) xb_add(&bar[XB_TOPGEN], 1u);
            else XB_SPIN(xb_ld(&bar[XB_TOPGEN]) == tg, bar);
            __builtin_amdgcn_fence(__ATOMIC_ACQUIRE, "agent");
            xb_add(&bar[XB_XGEN(b.x)], 1u);
            asm volatile("s_waitcnt vmcnt(0)" ::: "memory");
        } else {
            XB_SPIN(xb_ld(&bar[XB_XGEN(b.x)]) == gen, bar);
            __builtin_amdgcn_fence(__ATOMIC_ACQUIRE, "agent");
            asm volatile("s_waitcnt vmcnt(0)" ::: "memory");
        }
    }
    __syncthreads();
}


__device__ __forceinline__ void xcd_barrier_nofence(const XcdBarrier& b) {
    asm volatile("s_waitcnt vmcnt(0)" ::: "memory");
    __syncthreads();
    if (threadIdx.x == 0) {
        unsigned* bar = b.bar;
        __builtin_amdgcn_s_waitcnt(0);
        unsigned nloc = b.st[0], nx = b.st[1];
        if (nloc == 0u) { xcd_barrier_complete(bar, b.x, nloc, nx); b.st[0] = nloc; b.st[1] = nx; }
        const unsigned old = xb_add(&bar[XB_XSUB(b.x)], 1u);
        const unsigned gen = old / nloc;
        if (old + 1u == (gen + 1u) * nloc) {
            asm volatile("s_waitcnt vmcnt(0)" ::: "memory");
            const unsigned og = xb_add(&bar[XB_TOP], 1u);
            const unsigned tg = og / nx;
            if (og + 1u == (tg + 1u) * nx) xb_add(&bar[XB_TOPGEN], 1u);
            else XB_SPIN(xb_ld(&bar[XB_TOPGEN]) == tg, bar);
            xb_add(&bar[XB_XGEN(b.x)], 1u);
            asm volatile("s_waitcnt vmcnt(0)" ::: "memory");
        } else {
            XB_SPIN(xb_ld(&bar[XB_XGEN(b.x)]) == gen, bar);
            asm volatile("s_waitcnt vmcnt(0)" ::: "memory");
        }
    }
    __syncthreads();
}
using pg8::Unit;
__device__ __forceinline__ void st8(bf16_t* q, const f32x4 a, const f32x4 b) { u32x4 w; w.x = pk2(a[0], a[1]); w.y = pk2(a[2], a[3]); w.z = pk2(b[0], b[1]); w.w = pk2(b[2], b[3]); *(u32x4*)q = w; }
__device__ __forceinline__ f32x4 sig4(const f32x4 a) { f32x4 r; r[0] = sigmoidf_(a[0]); r[1] = sigmoidf_(a[1]); r[2] = sigmoidf_(a[2]); r[3] = sigmoidf_(a[3]); return r; }

struct Epi1a {
    static constexpr bool PERM = true, AFTER_DRAIN = false, MIDK = false;
    bf16_t* qkv; float* gates; const float* gate_b;
    __device__ __forceinline__ void operator()(const f32x4 (&acc)[2][2][4][2], const Unit& u, int wr, int wc, int fr, int fq) const {
        const int row0 = u.pm * 256 + wr * 64 + fr;
        if (u.pn < 12) {
            bf16_t* base = qkv + (size_t)(u.pn >> 2) * ((size_t)TOK * D) + (u.pn & 3) * 256 + wc * 32 + 8 * fq;
#pragma unroll
            for (int ai = 0; ai < 2; ++ai)
#pragma unroll
                for (int m = 0; m < 4; ++m) { bf16_t* rowp = base + (size_t)(row0 + ai * 128 + m * 16) * D;
#pragma unroll
                    for (int bj = 0; bj < 2; ++bj) st8(rowp + bj * 128, acc[ai][bj][m][0], acc[ai][bj][m][1]); }
        } else if (wc == 0) {
            const f32x4 b0 = *(const f32x4*)(gate_b + 8 * fq), b1 = *(const f32x4*)(gate_b + 8 * fq + 4);
#pragma unroll
            for (int ai = 0; ai < 2; ++ai)
#pragma unroll
                for (int m = 0; m < 4; ++m) { float* rowp = gates + (size_t)(row0 + ai * 128 + m * 16) * 32 + 8 * fq;
                    *(f32x4*)rowp = acc[ai][0][m][0] + b0; *(f32x4*)(rowp + 4) = acc[ai][0][m][1] + b1; }
        }
    }
};
struct Epi1b {
    static constexpr bool PERM = true, AFTER_DRAIN = false, MIDK = false;
    bf16_t *osb, *uu, *gmc;
    __device__ __forceinline__ void operator()(const f32x4 (&acc)[2][2][4][2], const Unit& u, int wr, int wc, int fr, int fq) const {
        const int row0 = u.pm * 256 + wr * 64 + fr, cl = wc * 32 + 8 * fq;
        if (u.pn >= 8 && u.pn < 16) {
            bf16_t* base = uu + (size_t)row0 * D + (u.pn - 8) * 128 + cl;
#pragma unroll
            for (int ai = 0; ai < 2; ++ai)
#pragma unroll
                for (int m = 0; m < 4; ++m) st8(base + (size_t)(ai * 128 + m * 16) * D, acc[ai][0][m][0] * acc[ai][1][m][0], acc[ai][0][m][1] * acc[ai][1][m][1]);
        } else {
            const int q = u.pn & 7;
            const int ld = u.pn < 8 ? 2 * D : D;
            bf16_t* base = u.pn < 8 ? osb + (size_t)row0 * ld + q * 256 + cl : gmc + (size_t)(q >> 2) * ((size_t)TOKL * D) + (size_t)row0 * D + (q & 3) * 256 + cl;
            if (u.pn >= 4 && u.pn < 8) {
#pragma unroll
                for (int ai = 0; ai < 2; ++ai)
#pragma unroll
                    for (int m = 0; m < 4; ++m)
#pragma unroll
                        for (int bj = 0; bj < 2; ++bj) st8(base + (size_t)(ai * 128 + m * 16) * ld + bj * 128, acc[ai][bj][m][0], acc[ai][bj][m][1]);
            } else {
#pragma unroll
                for (int ai = 0; ai < 2; ++ai)
#pragma unroll
                    for (int m = 0; m < 4; ++m)
#pragma unroll
                        for (int bj = 0; bj < 2; ++bj) st8(base + (size_t)(ai * 128 + m * 16) * ld + bj * 128, sig4(acc[ai][bj][m][0]), sig4(acc[ai][bj][m][1]));
            }
        }
    }
};
__device__ __forceinline__ f32x4 ld4bf(const bf16_t* q) { const u32x2 w = *(const u32x2*)q; f32x4 r; r[0] = bflo(w.x); r[1] = bfhi(w.x); r[2] = bflo(w.y); r[3] = bfhi(w.y); return r; }
struct EpiUp {
    static constexpr bool PERM = true, AFTER_DRAIN = false, MIDK = false;
    bf16_t *a, *g;
    __device__ __forceinline__ void operator()(const f32x4 (&acc)[2][2][4][2], const Unit& u, int wr, int wc, int fr, int fq) const {
        const int row0 = u.pm * 256 + wr * 64 + fr;
        bf16_t* base = (u.pn < 11 ? a + u.pn * 256 : g + (u.pn - 11) * 256) + wc * 32 + 8 * fq;
#pragma unroll
        for (int ai = 0; ai < 2; ++ai)
#pragma unroll
            for (int m = 0; m < 4; ++m) { bf16_t* rowp = base + (size_t)(row0 + ai * 128 + m * 16) * FF;
#pragma unroll
                for (int bj = 0; bj < 2; ++bj) st8(rowp + bj * 128, acc[ai][bj][m][0], acc[ai][bj][m][1]); }
    }
};
struct EpiMerge2 {
    static constexpr bool PERM = false, AFTER_DRAIN = false, MIDK = true;
    const bf16_t *gm, *gc; bf16_t* z;
    __device__ __forceinline__ void mid(f32x4 (&acc)[2][2][4][2], const Unit& u, int wr, int wc, int fr, int fq) const {
        int opq = 0; asm volatile("" : "+v"(opq));
        const int row0 = u.pm * 256 + wr * 64 + fr + opq, col0 = u.pn * 256 + wc * 32 + 4 * fq;
#pragma unroll
        for (int ai = 0; ai < 2; ++ai) { u32x2 ga[4][2][2], gb[4][2][2];
#pragma unroll
            for (int m = 0; m < 4; ++m) { const size_t off = (size_t)(row0 + ai * 128 + m * 16) * D + col0;
#pragma unroll
                for (int bj = 0; bj < 2; ++bj)
#pragma unroll
                    for (int n = 0; n < 2; ++n) { const size_t o2 = off + bj * 128 + n * 16; ga[m][bj][n] = *(const u32x2*)(gm + o2); gb[m][bj][n] = *(const u32x2*)(gc + o2); } }
#pragma unroll
            for (int m = 0; m < 4; ++m)
#pragma unroll
                for (int bj = 0; bj < 2; ++bj)
#pragma unroll
                    for (int n = 0; n < 2; ++n) { const u32x2 wa = ga[m][bj][n], wb = gb[m][bj][n]; f32x4 r;
                        r[0] = bflo(wa.x) * __builtin_amdgcn_rcpf(fmaxf(bflo(wb.x), 1e-30f)); r[1] = bfhi(wa.x) * __builtin_amdgcn_rcpf(fmaxf(bfhi(wb.x), 1e-30f));
                        r[2] = bflo(wa.y) * __builtin_amdgcn_rcpf(fmaxf(bflo(wb.y), 1e-30f)); r[3] = bfhi(wa.y) * __builtin_amdgcn_rcpf(fmaxf(bfhi(wb.y), 1e-30f));
                        acc[ai][bj][m][n] *= r; }
            asm volatile("" ::: "memory"); }
    }
    __device__ __forceinline__ void operator()(const f32x4 (&acc)[2][2][4][2], const Unit& u, int wr, int wc, int fr, int fq) const {
        const int row0 = u.pm * 256 + wr * 64 + fr, col0 = u.pn * 256 + wc * 32 + 4 * fq;
#pragma unroll
        for (int ai = 0; ai < 2; ++ai) { f32x4 gv[4][2][2];
#pragma unroll
            for (int m = 0; m < 4; ++m) { const size_t off = (size_t)(row0 + ai * 128 + m * 16) * D + col0;
#pragma unroll
                for (int bj = 0; bj < 2; ++bj)
#pragma unroll
                    for (int n = 0; n < 2; ++n) gv[m][bj][n] = ld4bf(gc + off + bj * 128 + n * 16); }
#pragma unroll
            for (int m = 0; m < 4; ++m) { const size_t off = (size_t)(row0 + ai * 128 + m * 16) * D + col0;
#pragma unroll
                for (int bj = 0; bj < 2; ++bj)
#pragma unroll
                    for (int n = 0; n < 2; ++n) { const size_t o2 = off + bj * 128 + n * 16; const f32x4 v = acc[ai][bj][m][n] * gv[m][bj][n]; u32x2 w; w.x = pk2(v[0], v[1]); w.y = pk2(v[2], v[3]); *(u32x2*)(z + o2) = w; } }
            asm volatile("" ::: "memory"); }
    }
};
template <int MODE> struct EpiResNorm {
    static constexpr bool PERM = false, AFTER_DRAIN = true, MIDK = false;
    const float* src; float* dst; const float* mod; int gidx; float* rowss; const XcdBarrier* xb; unsigned* panel;
    const float *ng, *shift, *scale; bf16_t* hx;
    __device__ __forceinline__ void fused(f32x4 (&acc)[2][2][4][2], const Unit& u, int wr, int wc, int fr, int fq, LAS unsigned char*, int, int) const {
        const int row0 = u.pm * 256 + wr * 64 + fr, col0 = u.pn * 256 + wc * 32 + 4 * fq, bidx = u.pm >> 3;
        const float* gt = mod + bidx * 6144 + gidx * 1024 + col0;
#pragma unroll
        for (int bj = 0; bj < 2; ++bj)
#pragma unroll
            for (int n = 0; n < 2; ++n) { const f32x4 gv = *(const f32x4*)(gt + bj * 128 + n * 16);
#pragma unroll
                for (int ai = 0; ai < 2; ++ai)
#pragma unroll
                    for (int m = 0; m < 4; ++m) acc[ai][bj][m][n] *= gv; }
#pragma unroll
        for (int ai = 0; ai < 2; ++ai) { f32x4 xin[4][2][2];
#pragma unroll
            for (int m = 0; m < 4; ++m) { const size_t off = (size_t)(row0 + ai * 128 + m * 16) * D + col0;
#pragma unroll
                for (int bj = 0; bj < 2; ++bj)
#pragma unroll
                    for (int n = 0; n < 2; ++n) xin[m][bj][n] = *(const f32x4*)(src + off + bj * 128 + n * 16); }
#pragma unroll
            for (int m = 0; m < 4; ++m) { const int row = row0 + ai * 128 + m * 16; float ss = 0.f;
#pragma unroll
                for (int bj = 0; bj < 2; ++bj)
#pragma unroll
                    for (int n = 0; n < 2; ++n) { const f32x4 v = acc[ai][bj][m][n] + xin[m][bj][n]; acc[ai][bj][m][n] = v; ss += (v[0] * v[0] + v[1] * v[1]) + (v[2] * v[2] + v[3] * v[3]); }
                ss += __shfl_xor(ss, 16); ss += __shfl_xor(ss, 32);
                if (fq == 0) (void)__hip_atomic_fetch_add(rowss + row, ss, __ATOMIC_RELAXED, __HIP_MEMORY_SCOPE_AGENT); }
            asm volatile("" ::: "memory"); }
        asm volatile("s_waitcnt vmcnt(0)" ::: "memory");
        __syncthreads();
        if (threadIdx.x == 0) { unsigned* pc = panel + 16 * u.pm; (void)xb_add(pc, 1u); XB_SPIN(xb_ld(pc) < 4u, xb->bar); }
        __syncthreads();
        f32x4 gs[2][2], sh[2][2];
#pragma unroll
        for (int bj = 0; bj < 2; ++bj)
#pragma unroll
            for (int n = 0; n < 2; ++n) { const int c = col0 + bj * 128 + n * 16;
                if (MODE == 0) { gs[bj][n] = *(const f32x4*)(ng + c) * (*(const f32x4*)(scale + bidx * 6144 + c) + 1.0f); sh[bj][n] = *(const f32x4*)(shift + bidx * 6144 + c); }
                else { gs[bj][n] = *(const f32x4*)(ng + c); sh[bj][n] = (f32x4){0.f, 0.f, 0.f, 0.f}; } }
        float rsum[2][4];
#pragma unroll
        for (int ai = 0; ai < 2; ++ai)
#pragma unroll
            for (int m = 0; m < 4; ++m) rsum[ai][m] = __hip_atomic_load(rowss + row0 + ai * 128 + m * 16, __ATOMIC_RELAXED, __HIP_MEMORY_SCOPE_AGENT);
#pragma unroll
        for (int ai = 0; ai < 2; ++ai)
#pragma unroll
            for (int m = 0; m < 4; ++m) { const int row = row0 + ai * 128 + m * 16; const size_t off = (size_t)row * D + col0;
                const float rstd = rsqrtf(rsum[ai][m] * (1.0f / D) + EPS);
#pragma unroll
                for (int bj = 0; bj < 2; ++bj)
#pragma unroll
                    for (int n = 0; n < 2; ++n) { const size_t o2 = off + bj * 128 + n * 16; const f32x4 v = acc[ai][bj][m][n]; const f32x4 y = v * rstd * gs[bj][n] + sh[bj][n];
                        if (MODE == 0) { *(f32x4*)(dst + o2) = v; u32x2 w; w.x = pk2(y[0], y[1]); w.y = pk2(y[2], y[3]); *(u32x2*)(hx + o2) = w; }
                        else *(f32x4*)(dst + o2) = y; }
                asm volatile("" ::: "memory"); }
    }
};
template <class Epi> __device__ __forceinline__ void run_gemm(LAS unsigned char* lds, const bf16_t* A, const bf16_t* Bt, int M, int N, int K, const Epi& E) {
    pg8::StaticOrder S; S.init(M, N, (int)gridDim.x, (int)blockIdx.x);
    pg8::Gemm g; g.A = A; g.Bt = Bt; g.M = M; g.N = N; g.K = K;
    pg8::gemm_phase<Epi, pg8::StaticOrder, !Epi::AFTER_DRAIN, true>(lds, g, S, E);
    __syncthreads();
}

__device__ __forceinline__ void phase2b(const Params& p) {
    const int gt = blockIdx.x * NT + otid(), ngrp = (gridDim.x * NT) >> 8;
    const int cc = gt & 255, isk = cc >> 7, col = (cc & 127) * 8;
    const bf16_t* src = (const bf16_t*)(p.ws + OFF_QKV) + (size_t)isk * ((size_t)TOK * D) + col;
    bf16_t* dst = (isk ? (bf16_t*)(p.ws + OFF_K) : (bf16_t*)p.out) + col;
    float w0[8], w1[8], w2[8], bb[8];
#pragma unroll
    for (int j = 0; j < 8; ++j) { const int wcn = isk * 1024 + col + j; w0[j] = p.qk_conv_w[wcn]; w1[j] = p.qk_conv_w[2048 + wcn]; w2[j] = p.qk_conv_w[4096 + wcn]; bb[j] = p.qk_conv_b[wcn]; }
    const float osc = isk ? 0.08838834764831845f : 1.0f;
    const int per = (TOK + ngrp - 1) / ngrp, nper = (per + 3) & ~3;
    const u32x4 zero = (u32x4){0u, 0u, 0u, 0u};
    for (int g = gt >> 8; g * nper < TOK; g += ngrp) {
        const int R0 = g * nper;
        u32x4 prev = R0 > 0 ? *(const u32x4*)(src + (size_t)(R0 - 1) * D) : zero, cur = *(const u32x4*)(src + (size_t)R0 * D);
        for (int i = 0; i < nper && R0 + i < TOK; i += 4) {
            u32x4 nx[4];
#pragma unroll
            for (int j = 0; j < 4; ++j) { const int Rn = R0 + i + j + 1; nx[j] = Rn < TOK ? *(const u32x4*)(src + (size_t)Rn * D) : zero; }
#pragma unroll
            for (int j = 0; j < 4; ++j) { const int R = R0 + i + j;
                if (R < TOK) {
                    int t, T; if (R < TOKC) { t = R & (CTXL - 1); T = CTXL; } else { t = (R - TOKC) & (SEQ - 1); T = SEQ; }
                    float f0[8], f1[8], f2[8], o[8]; unpack8(t > 0 ? prev : zero, f0); unpack8(cur, f1); unpack8(t < T - 1 ? nx[j] : zero, f2);
#pragma unroll
                    for (int e = 0; e < 8; ++e) { const float a = w0[e] * f0[e] + w1[e] * f1[e] + w2[e] * f2[e] + bb[e]; o[e] = a * sigmoidf_(a) * osc; }
                    *(u32x4*)(dst + (size_t)R * D) = pack8(o);
                }
                prev = cur; cur = nx[j]; }
        }
    }
}

__device__ __forceinline__ void phase5(const Params& p) {
    const int tid_ = otid(), lane = tid_ & 63, gw = blockIdx.x * 8 + (tid_ >> 6), ngw = gridDim.x * 8;
    const bf16_t* hf = (const bf16_t*)(p.ws + OFF_HF); const bf16_t* hb = (const bf16_t*)(p.ws + OFF_HB);
    bf16_t* ob = (bf16_t*)(p.ws + OFF_O); bf16_t* sbb = ob + D; const bf16_t* ub = (const bf16_t*)(p.ws + OFF_U);
    const int c0 = lane * 16;
    float mg[16], cw0[16], cw1[16], cw2[16], cbb[16];
#pragma unroll
    for (int j = 0; j < 16; ++j) { mg[j] = p.mnorm_g[c0 + j]; cw0[j] = p.sc_conv_w[c0 + j]; cw1[j] = p.sc_conv_w[1024 + c0 + j]; cw2[j] = p.sc_conv_w[2048 + c0 + j]; cbb[j] = p.sc_conv_b[c0 + j]; }
    const u32x4 zero = (u32x4){0u, 0u, 0u, 0u};
    for (int r0 = gw * 8; r0 < TOKL; r0 += ngw * 8) {
        u32x4 up[2], uc[2], un[2];
        { const int t0 = r0 & (SEQ - 1); const bf16_t* q = ub + (size_t)r0 * D + c0;
          up[0] = t0 > 0 ? *(const u32x4*)(q - D) : zero; up[1] = t0 > 0 ? *(const u32x4*)(q - D + 8) : zero; uc[0] = *(const u32x4*)q; uc[1] = *(const u32x4*)(q + 8); }
        for (int i = 0; i < 8; ++i) {
            const int row = r0 + i, t = row & (SEQ - 1);
            const size_t off = (size_t)row * D + c0, off2 = (size_t)row * (2 * D) + c0;
            const u32x4 hfa = *(const u32x4*)(hf + off), hfb = *(const u32x4*)(hf + off + 8), hba = *(const u32x4*)(hb + off), hbb = *(const u32x4*)(hb + off + 8);
            const u32x4 oa = *(const u32x4*)(ob + off2), obv = *(const u32x4*)(ob + off2 + 8), sa = *(const u32x4*)(sbb + off2), sbv = *(const u32x4*)(sbb + off2 + 8);
            un[0] = t < SEQ - 1 ? *(const u32x4*)(ub + off + D) : zero; un[1] = t < SEQ - 1 ? *(const u32x4*)(ub + off + D + 8) : zero;
            float h[16], so[16];
            { float a[8], b[8]; unpack8(hfa, a); unpack8(hba, b);
#pragma unroll
              for (int j = 0; j < 8; ++j) h[j] = a[j] + b[j];
              unpack8(hfb, a); unpack8(hbb, b);
#pragma unroll
              for (int j = 0; j < 8; ++j) h[8 + j] = a[j] + b[j];
              unpack8(oa, a);
#pragma unroll
              for (int j = 0; j < 8; ++j) so[j] = a[j];
              unpack8(obv, a);
#pragma unroll
              for (int j = 0; j < 8; ++j) so[8 + j] = a[j]; }
            float ss = 0.f;
#pragma unroll
            for (int j = 0; j < 16; ++j) ss += h[j] * h[j];
            ss += __shfl_xor(ss, 1); ss += __shfl_xor(ss, 2); ss += __shfl_xor(ss, 4);
            const float rstd = rsqrtf(ss * (1.0f / 128.0f) + EPS);
            { float a[8];
#pragma unroll
              for (int j = 0; j < 8; ++j) a[j] = h[j] * rstd * mg[j] * so[j];
              *(u32x4*)(ob + off2) = pack8(a);
#pragma unroll
              for (int j = 0; j < 8; ++j) a[j] = h[8 + j] * rstd * mg[8 + j] * so[8 + j];
              *(u32x4*)(ob + off2 + 8) = pack8(a); }
#pragma unroll
            for (int hv = 0; hv < 2; ++hv) {
                float u0[8], u1[8], u2[8], s[8], o[8];
                unpack8(t > 0 ? up[hv] : zero, u0); unpack8(uc[hv], u1); unpack8(un[hv], u2); unpack8(hv ? sbv : sa, s);
#pragma unroll
                for (int j = 0; j < 8; ++j) o[j] = s[j] * (cw0[hv * 8 + j] * u0[j] + cw1[hv * 8 + j] * u1[j] + cw2[hv * 8 + j] * u2[j] + cbb[hv * 8 + j]);
                *(u32x4*)(sbb + off2 + hv * 8) = pack8(o);
                up[hv] = uc[hv]; uc[hv] = un[hv];
            }
        }
    }
}

__device__ __forceinline__ void phase10(const Params& p) {
    const int tid = otid(); const bf16_t* A = (const bf16_t*)(p.ws + OFF_A); bf16_t* G = (bf16_t*)(p.ws + OFF_G);
    if (tid >= FF / 8) return;
    const int c0 = tid * 8;
    float wt[9][8], bb[8];
#pragma unroll
    for (int q = 0; q < 9; ++q)
#pragma unroll
        for (int j = 0; j < 8; ++j) wt[q][j] = p.ff_conv_w[q * FF + c0 + j];
#pragma unroll
    for (int j = 0; j < 8; ++j) bb[j] = p.ff_conv_b[c0 + j];
    const u32x4 zero = (u32x4){0u, 0u, 0u, 0u};
#define P10_COLSUM(col, n0, n1, n2) do { float f_[8]; unpack8((col)[0], f_); _Pragma("unroll") for (int e = 0; e < 8; ++e) { n0[e] = wt[0][e] * f_[e]; n1[e] = wt[1][e] * f_[e]; n2[e] = wt[2][e] * f_[e]; } \
        unpack8((col)[1], f_); _Pragma("unroll") for (int e = 0; e < 8; ++e) { n0[e] += wt[3][e] * f_[e]; n1[e] += wt[4][e] * f_[e]; n2[e] += wt[5][e] * f_[e]; } \
        unpack8((col)[2], f_); _Pragma("unroll") for (int e = 0; e < 8; ++e) { n0[e] += wt[6][e] * f_[e]; n1[e] += wt[7][e] * f_[e]; n2[e] += wt[8][e] * f_[e]; } } while (0)
    for (int it = blockIdx.x; it < 256; it += gridDim.x) {
        const int item = ((it & 7) << 5) | (it >> 3), b = item >> 5, r = item & 31;
        const size_t rowbase = ((size_t)b * SEQ + (size_t)r * 64) * FF + c0;
        const bool rv[3] = {r > 0, true, r < 31};
        float sA[8], sB1[8], sBc0[8];
        { u32x4 col0[3];
#pragma unroll
          for (int dr = 0; dr < 3; ++dr) col0[dr] = rv[dr] ? *(const u32x4*)(A + rowbase + (ptrdiff_t)(dr - 1) * 64 * FF) : zero;
          float n2[8]; P10_COLSUM(col0, sBc0, sB1, n2);
#pragma unroll
          for (int e = 0; e < 8; ++e) sA[e] = 0.f; }
        u32x4 cur[2][3], gq[2];
#pragma unroll
        for (int j = 0; j < 2; ++j) { gq[j] = *(const u32x4*)(G + rowbase + (size_t)j * FF);
#pragma unroll
            for (int dr = 0; dr < 3; ++dr) cur[j][dr] = rv[dr] ? *(const u32x4*)(A + rowbase + (ptrdiff_t)(dr - 1) * 64 * FF + (size_t)(1 + j) * FF) : zero; }
        for (int w = 0; w < 64; w += 2) {
            u32x4 nxt[2][3], gn[2];
#pragma unroll
            for (int j = 0; j < 2; ++j) { const int x = w + 3 + j;
                gn[j] = (w + 2 + j < 64) ? *(const u32x4*)(G + rowbase + (size_t)(w + 2 + j) * FF) : zero;
#pragma unroll
                for (int dr = 0; dr < 3; ++dr) nxt[j][dr] = (rv[dr] && x < 64) ? *(const u32x4*)(A + rowbase + (ptrdiff_t)(dr - 1) * 64 * FF + (size_t)x * FF) : zero; }
#pragma unroll
            for (int j = 0; j < 2; ++j) {
                float n0[8], n1[8], n2[8]; P10_COLSUM(cur[j], n0, n1, n2);
                float gg[8], o[8]; unpack8(gq[j], gg);
#pragma unroll
                for (int e = 0; e < 8; ++e) { const float a = sA[e] + sB1[e] + n2[e] + bb[e]; const float y2 = 1.5957691216057308f * (a + 0.044715f * a * a * a); o[e] = a * sigmoidf_(y2) * gg[e];
                    sA[e] = sBc0[e]; sB1[e] = n1[e]; sBc0[e] = n0[e]; }
                *(u32x4*)(G + rowbase + (size_t)(w + j) * FF) = pack8(o);
            }
#pragma unroll
            for (int j = 0; j < 2; ++j) { gq[j] = gn[j];
#pragma unroll
                for (int dr = 0; dr < 3; ++dr) cur[j][dr] = nxt[j][dr]; }
        }
    }
#undef P10_COLSUM
}
constexpr int QP = 272, VP = 224, CP = 272;
constexpr int L_Q = 0, L_K = 34816, L_V = 69632, L_VW = 98304, L_CB = 126976, L_GV = 148736, L_WK = 151808;
__device__ __forceinline__ bf16x8 tr8(LAS unsigned char* a0, LAS unsigned char* a1) {
    const bf16x4 lo = __builtin_amdgcn_ds_read_tr16_b64_v4i16((LAS bf16x4*)a0);
    const bf16x4 hi = __builtin_amdgcn_ds_read_tr16_b64_v4i16((LAS bf16x4*)a1);
    return __builtin_shufflevector(lo, hi, 0, 1, 2, 3, 4, 5, 6, 7);
}
__device__ __forceinline__ bf16x8 as_bf16x8(const u32x4 w) { union { u32x4 u; bf16x8 b; } c; c.u = w; return c.b; }
#define MFMA16(a, b, c) __builtin_amdgcn_mfma_f32_16x16x32_bf16((a), (b), (c), 0, 0, 0)
__device__ __forceinline__ void mlstm_load(int ci, int dir, int b, int h, int e0, int tid, int lane, int w, const bf16_t* Qg, const bf16_t* Kg, const bf16_t* Vg, const float* gates,
                                           u32x4 (&qreg)[4], u32x4 (&kreg)[4], u32x4 (&vreg)[2], float (&graw)[4]) {
    const bool emit = ci >= 2;
    const int cs = emit ? ci - 2 : ci, T = emit ? SEQ : CTXL, rbase = emit ? TOKC + b * SEQ : b * CTXL;
    const int tb = dir ? T - 1 - cs * 128 : cs * 128, ts = dir ? -1 : 1;
#pragma unroll
    for (int i = 0; i < 4; ++i) { const int n = tid + NT * i, j = n >> 4, ch = n & 15; const size_t ro = (size_t)(rbase + tb + ts * j) * D + h * 128 + ch * 8;
        kreg[i] = *(const u32x4*)(Kg + ro); if (emit) qreg[i] = *(const u32x4*)(Qg + ro); }
#pragma unroll
    for (int i = 0; i < 2; ++i) { const int n = tid + NT * i, j = n >> 3, ch = n & 7; vreg[i] = *(const u32x4*)(Vg + (size_t)(rbase + tb + ts * j) * D + h * 128 + e0 + ch * 8); }
    if (w == 0) { const int j0 = 2 * lane; const size_t r0 = (size_t)(rbase + tb + ts * j0) * 32 + dir * 16 + h, r1 = (size_t)(rbase + tb + ts * (j0 + 1)) * 32 + dir * 16 + h;
        graw[0] = gates[r0]; graw[1] = gates[r0 + 8]; graw[2] = gates[r1]; graw[3] = gates[r1 + 8]; }
}
__device__ __forceinline__ void mlstm_gates(int lane, const float (&graw)[4], float mst, LAS float* gvS, LAS float* MS, LAS float* bS) {
    const int j0 = 2 * lane;
    const float ig0 = graw[0], f0 = graw[1], ig1 = graw[2], f1 = graw[3];
    const float lf0 = fminf(f0, 0.f) - log1pf(expf(-fabsf(f0))), lf1 = fminf(f1, 0.f) - log1pf(expf(-fabsf(f1)));
    float s = lf0 + lf1;
#pragma unroll
    for (int o = 1; o < 64; o <<= 1) { const float t = __shfl_up(s, o); if (lane >= o) s += t; }
    const float b0 = s - lf1, b1 = s;
    const float gv0 = ig0 - b0, gv1 = ig1 - b1;
    float mx = fmaxf(gv0, gv1);
#pragma unroll
    for (int o = 1; o < 64; o <<= 1) { const float t = __shfl_up(mx, o); if (lane >= o) mx = fmaxf(mx, t); }
    float pe = __shfl_up(mx, 1); if (lane == 0) pe = -3.0e38f;
    const float pm0 = fmaxf(pe, gv0), pm1 = mx;
    gvS[j0] = gv0; gvS[j0 + 1] = gv1; MS[j0] = fmaxf(mst, pm0); MS[j0 + 1] = fmaxf(mst, pm1); bS[j0] = b0; bS[j0 + 1] = b1;
}
__device__ __forceinline__ void phase3(const Params& p, LAS unsigned char* lds) {
    const int tid = otid(), lane = tid & 63, w = __builtin_amdgcn_readfirstlane(tid >> 6), g = lane >> 4, l15 = lane & 15, q4 = l15 >> 2, p4 = l15 & 3;
    const int itile = w < 4 ? w : 11 - w;
    const bf16_t* Qg = (const bf16_t*)p.out; const bf16_t* Kg = (const bf16_t*)(p.ws + OFF_K); const bf16_t* Vg = (const bf16_t*)(p.ws + OFF_V);
    const float* gates = (const float*)(p.ws + OFF_GATES);
    LAS unsigned char* Qs = lds + L_Q; LAS unsigned char* Ks = lds + L_K; LAS unsigned char* Vs = lds + L_V; LAS unsigned char* VWs = lds + L_VW; LAS unsigned char* Cbs = lds + L_CB;
    LAS float* gvS0 = (LAS float*)(lds + L_GV);
    const f32x4 zero4 = (f32x4){0.f, 0.f, 0.f, 0.f};
    for (int blk = blockIdx.x; blk < 256; blk += gridDim.x) {
        const int xcd = blk & 7, slot = blk >> 3, grp = xcd * 8 + (slot >> 2), sub = slot & 3, dir = sub >> 1, eh = sub & 1, b = grp >> 3, h = grp & 7, e0 = eh * 64;
        bf16_t* Hout = (bf16_t*)(p.ws + (dir ? OFF_HB : OFF_HF));
        f32x4 Cacc[5];
#pragma unroll
        for (int c = 0; c < 5; ++c) Cacc[c] = zero4;
        float mst = -1e30f;
        for (int i = tid; i < 80 * CP / 4; i += NT) ((LAS unsigned*)Cbs)[i] = 0u;
        __syncthreads();
        u32x4 qreg[4], kreg[4], vreg[2]; float graw[4];
        mlstm_load(0, dir, b, h, e0, tid, lane, w, Qg, Kg, Vg, gates, qreg, kreg, vreg, graw);
        if (w == 0) mlstm_gates(lane, graw, mst, gvS0, gvS0 + 128, gvS0 + 256);
        __syncthreads();
        for (int ci = 0; ci < 18; ++ci) {
            const bool emit = ci >= 2;
            const int cs = emit ? ci - 2 : ci, T = emit ? SEQ : CTXL, rbase = emit ? TOKC + b * SEQ : b * CTXL;
            const int tb = dir ? T - 1 - cs * 128 : cs * 128, ts = dir ? -1 : 1;
            LAS float* gvS = gvS0 + (ci & 1) * 384; LAS float* MS = gvS + 128; LAS float* bS = gvS + 256; LAS float* gvN = gvS0 + ((ci + 1) & 1) * 384;
            const float M127 = MS[127], bend = bS[127];
            const float decay = __expf(mst - M127);
#pragma unroll
            for (int i = 0; i < 4; ++i) { const int n = tid + NT * i, j = n >> 4, ch = n & 15; *(LAS u32x4*)(Ks + j * QP + ch * 16) = kreg[i]; if (emit) *(LAS u32x4*)(Qs + j * QP + ch * 16) = qreg[i]; }
#pragma unroll
            for (int i = 0; i < 2; ++i) { const int n = tid + NT * i, j = n >> 3, ch = n & 7;
                const float wk = __expf(gvS[j] - M127); float f[8]; unpack8(vreg[i], f);
#pragma unroll
                for (int e = 0; e < 8; ++e) f[e] *= wk;
                *(LAS u32x4*)(VWs + j * VP + ch * 16) = pack8(f); }
            if (tid < 128) { const float wk = __expf(gvS[tid] - M127); *(LAS u32x4*)(VWs + tid * VP + 128) = (u32x4){pk2(wk, 0.f), 0u, 0u, 0u}; *(LAS u32x4*)(VWs + tid * VP + 144) = (u32x4){0u, 0u, 0u, 0u}; }
            if (ci + 1 < 18) mlstm_load(ci + 1, dir, b, h, e0, tid, lane, w, Qg, Kg, Vg, gates, qreg, kreg, vreg, graw);
            __syncthreads();
            if (emit) {
                bf16x8 qf[4];
#pragma unroll
                for (int ks = 0; ks < 4; ++ks) qf[ks] = *(const LAS bf16x8*)(Qs + (16 * itile + l15) * QP + (32 * ks + 8 * g) * 2);
                f32x4 oacc[5];
#pragma unroll
                for (int c = 0; c < 5; ++c) oacc[c] = zero4;
#pragma unroll
                for (int ks = 0; ks < 4; ++ks) { bf16x8 cb[5];
#pragma unroll
                    for (int c = 0; c < 5; ++c) cb[c] = *(const LAS bf16x8*)(Cbs + (16 * c + l15) * CP + (32 * ks + 8 * g) * 2);
                    __builtin_amdgcn_sched_barrier(0);
#pragma unroll
                    for (int c = 0; c < 5; ++c) oacc[c] = MFMA16(qf[ks], cb[c], oacc[c]);
                    __builtin_amdgcn_sched_barrier(0); }
#pragma unroll
                for (int c = 0; c < 5; ++c) oacc[c] *= decay;
                const int iq = 16 * itile + l15;
#pragma unroll
                for (int s = 0; s < 4; ++s) if (s <= (itile >> 1)) {
                    const int jt0 = 2 * s, jt1 = 2 * s + 1;
                    f32x4 st0 = zero4, st1 = zero4;
                    bf16x8 kf0[4], kf1[4], vb[5];
#pragma unroll
                    for (int ks = 0; ks < 4; ++ks) { kf0[ks] = *(const LAS bf16x8*)(Ks + (16 * jt0 + l15) * QP + (32 * ks + 8 * g) * 2); kf1[ks] = *(const LAS bf16x8*)(Ks + (16 * jt1 + l15) * QP + (32 * ks + 8 * g) * 2); }
#pragma unroll
                    for (int c = 0; c < 5; ++c) vb[c] = tr8(VWs + (32 * s + 4 * g + q4) * VP + (16 * c + 4 * p4) * 2, VWs + (32 * s + 16 + 4 * g + q4) * VP + (16 * c + 4 * p4) * 2);
                    __builtin_amdgcn_sched_barrier(0);
#pragma unroll
                    for (int ks = 0; ks < 4; ++ks) { st0 = MFMA16(kf0[ks], qf[ks], st0); st1 = MFMA16(kf1[ks], qf[ks], st1); }
                    __builtin_amdgcn_sched_barrier(0);
#pragma unroll
                    for (int r = 0; r < 4; ++r) { const int ja = 16 * jt0 + 4 * g + r, jb = 16 * jt1 + 4 * g + r;
                        st0[r] = (ja <= iq) ? st0[r] : 0.f; st1[r] = (jb <= iq) ? st1[r] : 0.f; }
                    u32x4 pw; pw.x = pk2(st0[0], st0[1]); pw.y = pk2(st0[2], st0[3]); pw.z = pk2(st1[0], st1[1]); pw.w = pk2(st1[2], st1[3]);
                    const bf16x8 pa = as_bf16x8(pw);
#pragma unroll
                    for (int c = 0; c < 5; ++c) oacc[c] = MFMA16(pa, vb[c], oacc[c]);
                    __builtin_amdgcn_sched_barrier(0);
                }
                { const f32x4 bi = *(const LAS f32x4*)(bS + 16 * itile + 4 * g);
#pragma unroll
                  for (int r = 0; r < 4; ++r) { const float den = __shfl(oacc[4][r], lane & 48); const float inv = 1.0f / fmaxf(fabsf(den), __expf(-(bi[r] + M127)));
                      const int ir = 16 * itile + 4 * g + r; bf16_t* hp = Hout + (size_t)(b * SEQ + tb + ts * ir) * D + h * 128 + e0 + l15;
#pragma unroll
                      for (int c = 0; c < 4; ++c) hp[16 * c] = (bf16_t)(pk2(oacc[c][r] * inv, 0.f) & 0xffffu); } }
            }
#pragma unroll
            for (int c = 0; c < 5; ++c) Cacc[c] *= decay;
#pragma unroll
            for (int ks = 0; ks < 4; ++ks) { bf16x8 vw[5];
                const bf16x8 ka = tr8(Ks + (32 * ks + 4 * g + q4) * QP + (16 * w + 4 * p4) * 2, Ks + (32 * ks + 16 + 4 * g + q4) * QP + (16 * w + 4 * p4) * 2);
#pragma unroll
                for (int c = 0; c < 5; ++c) vw[c] = tr8(VWs + (32 * ks + 4 * g + q4) * VP + (16 * c + 4 * p4) * 2, VWs + (32 * ks + 16 + 4 * g + q4) * VP + (16 * c + 4 * p4) * 2);
                __builtin_amdgcn_sched_barrier(0);
#pragma unroll
                for (int c = 0; c < 5; ++c) Cacc[c] = MFMA16(ka, vw[c], Cacc[c]);
                __builtin_amdgcn_sched_barrier(0); }
            mst = bend + M127;
            if (w == 0 && ci + 1 < 18) mlstm_gates(lane, graw, mst, gvN, gvN + 128, gvN + 256);
            __syncthreads();
#pragma unroll
            for (int c = 0; c < 5; ++c) { u32x2 cw; cw.x = pk2(Cacc[c][0], Cacc[c][1]); cw.y = pk2(Cacc[c][2], Cacc[c][3]); *(LAS u32x2*)(Cbs + (16 * c + l15) * CP + (16 * w + 4 * g) * 2) = cw; }
        }
        __syncthreads();
    }
}
constexpr int NPHASE = 15;
template <int PH> __device__ __forceinline__ void run_phase(const Params& p, LAS unsigned char* lds, const XcdBarrier* xbp) {
    unsigned char* ws = p.ws;
    if constexpr (PH == 0) phase0(p, lds);
    if constexpr (PH == 1) phase1(p);
    if constexpr (PH == 2) { Epi1a E; E.qkv = (bf16_t*)(ws + OFF_QKV); E.gates = (float*)(ws + OFF_GATES); E.gate_b = p.gate_b;
        run_gemm(lds, (const bf16_t*)(ws + OFF_AH), (const bf16_t*)(ws + OFF_WIN), TOK, N1A, D, E); }
    if constexpr (PH == 3) phase2b(p);
    if constexpr (PH == 4) phase3(p, lds);
    if constexpr (PH == 5) { Epi1b E; E.osb = (bf16_t*)(ws + OFF_O); E.uu = (bf16_t*)(ws + OFF_U); E.gmc = (bf16_t*)p.out;
        run_gemm(lds, (const bf16_t*)(ws + OFF_AH) + (size_t)TOKC * D, (const bf16_t*)(ws + OFF_WIN) + (size_t)N1A * D, TOKL, N1B, D, E); }
    if constexpr (PH == 6) phase5(p);
    if constexpr (PH == 7) { EpiMerge2 E; E.gm = (const bf16_t*)p.out; E.gc = (const bf16_t*)p.out + (size_t)TOKL * D; E.z = (bf16_t*)(ws + OFF_Z);
        run_gemm(lds, (const bf16_t*)(ws + OFF_O), (const bf16_t*)(ws + OFF_WM), TOKL, D, 2 * D, E); }
    if constexpr (PH == 9) { EpiResNorm<0> E; E.src = p.x; E.dst = p.out; E.mod = (const float*)(ws + OFF_MOD); E.gidx = 2; E.rowss = (float*)(ws + OFF_RS); E.xb = xbp; E.panel = (unsigned*)(ws + OFF_HCTR + 1024);
        E.ng = p.norm2_g; E.shift = (const float*)(ws + OFF_MOD) + 3 * 1024; E.scale = (const float*)(ws + OFF_MOD) + 4 * 1024; E.hx = (bf16_t*)(ws + OFF_HX2);
        run_gemm(lds, (const bf16_t*)(ws + OFF_Z), (const bf16_t*)(ws + OFF_WO), TOKL, D, D, E); }
    if constexpr (PH == 11) { EpiUp E; E.a = (bf16_t*)(ws + OFF_A); E.g = (bf16_t*)(ws + OFF_G);
        run_gemm(lds, (const bf16_t*)(ws + OFF_HX2), (const bf16_t*)(ws + OFF_WUP), TOKL, 2 * FF, D, E); }
    if constexpr (PH == 12) phase10(p);
    if constexpr (PH == 13) { EpiResNorm<1> E; E.src = p.out; E.dst = p.out; E.mod = (const float*)(ws + OFF_MOD); E.gidx = 5; E.rowss = (float*)(ws + OFF_RS) + TOKL; E.xb = xbp; E.panel = (unsigned*)(ws + OFF_HCTR + 1024 + 4096);
        E.ng = p.final_g; E.shift = nullptr; E.scale = nullptr; E.hx = nullptr;
        run_gemm(lds, (const bf16_t*)(ws + OFF_G), (const bf16_t*)(ws + OFF_WDN), TOKL, D, FF, E); }
}
template <int PH> __device__ __forceinline__ void run_all(const Params& p, LAS unsigned char* lds, cg::grid_group& grid, const XcdBarrier& xb) {
    run_phase<PH>(p, lds, &xb);
    if constexpr (PH == 0) {
        if (threadIdx.x == 0) XB_SPIN(xb_ld((unsigned*)(p.ws + OFF_HCTR)) < 192u, xb.bar);
        __syncthreads();
        __builtin_amdgcn_fence(__ATOMIC_ACQUIRE, "agent");
    }
    if constexpr (PH == 4) xcd_barrier_nofence(xb);
    if constexpr (PH + 1 < NPHASE) { if constexpr (PH != 0 && PH != 4 && PH != 8 && PH != 10 && PH != 13) xcd_barrier(xb);
        run_all<PH + 1>(p, lds, grid, xb); }
}
__global__ __launch_bounds__(NT) void k_mega(Params p) {
    extern __shared__ __attribute__((aligned(16))) unsigned char shm[];
    cg::grid_group grid = cg::this_grid();
    volatile LAS unsigned* st = (volatile LAS unsigned*)((LAS unsigned char*)shm + LDS_BYTES - 16);
    if (threadIdx.x < 4) st[threadIdx.x] = 0u;
    __syncthreads();
    const XcdBarrier xb = xcd_barrier_post((unsigned*)(p.ws + OFF_BAR), st);
    if (p.ws == nullptr) grid.sync();
    run_all<0>(p, (LAS unsigned char*)shm, grid, xb);
}

extern "C" void kernel_launch(void* const* d_in, const int* in_sizes, int n_in, void* d_out, int out_size, void* d_ws, size_t ws_size, hipStream_t stream) {
    static int grid = 0;
    if (grid == 0) {
        if (n_in != 23 || in_sizes[0] != TOKL * D || out_size != TOKL * D || ws_size < WS_NEED) {
            fprintf(stderr, "kernel_launch: unexpected shapes (n_in %d, in0 %d, out %d, ws %zu); nothing launched\n", n_in, n_in > 0 ? in_sizes[0] : -1, out_size, ws_size); grid = -1; return; }
        int dev = 0, cus = 0, per_cu = 0;
        hipGetDevice(&dev); hipDeviceGetAttribute(&cus, hipDeviceAttributeMultiprocessorCount, dev);
        if (hipFuncSetAttribute((const void*)k_mega, hipFuncAttributeMaxDynamicSharedMemorySize, LDS_BYTES) != hipSuccess) { fprintf(stderr, "kernel_launch: hipFuncSetAttribute failed\n"); grid = -1; return; }
        if (hipOccupancyMaxActiveBlocksPerMultiprocessor(&per_cu, (const void*)k_mega, NT, LDS_BYTES) != hipSuccess || per_cu < 1) { fprintf(stderr, "kernel_launch: occupancy query gave %d blocks per CU\n", per_cu); (void)hipGetLastError(); per_cu = 1; }
        grid = cus;
        if (grid != 256) fprintf(stderr, "kernel_launch: built for 256 CUs (the fused-norm GEMM epilogues need exactly one 256x256 unit per workgroup); got %d\n", grid);
    }
    if (grid < 0) return;
    Params p{};
    const float** f = (const float**)&p;
    for (int i = 0; i < 23; ++i) f[i] = (const float*)d_in[i];
    p.out = (float*)d_out; p.ws = (unsigned char*)d_ws;
    if (hipMemsetAsync((char*)d_ws + OFF_MOD, 0, (OFF_BAR - OFF_MOD) + ZERO_BYTES, stream) != hipSuccess) { fprintf(stderr, "kernel_launch: memset of the barrier words failed\n"); return; }
    void* args[] = {&p};
    hipError_t e = hipLaunchCooperativeKernel((const void*)k_mega, dim3(grid), dim3(NT), args, LDS_BYTES, stream);
    if (e != hipSuccess) fprintf(stderr, "cooperative launch failed: %s (grid %d)\n", hipGetErrorString(e), grid);
}
```

```cpp
#include <hip/hip_runtime.h>
#include <hip/hip_cooperative_groups.h>
#include <cstdio>
#include <cstdint>
namespace cg = cooperative_groups;
__device__ __forceinline__ int otid() { int t = (int)threadIdx.x; asm volatile("" : "+v"(t)); return t; }
namespace pg8 {
#define PG8_LAS __attribute__((address_space(3)))
typedef unsigned short bf16_t;
typedef short bf16x8 __attribute__((ext_vector_type(8)));
typedef float f32x4 __attribute__((ext_vector_type(4)));
typedef unsigned u32x4 __attribute__((ext_vector_type(4)));
constexpr int BM = 256, BK = 64, HALF = 128, HTB = HALF * BK * 2, STAGE_BYTES = 8 * HTB, NXCD = 8, WGM = 8;
__host__ __device__ __forceinline__ int lds_byte(int r, int c) { const int st = (r >> 4) * 2 + (c >> 5), rr = r & 15, cc = c & 31, ob = rr * 64 + cc * 2; return st * 1024 + (ob ^ (((ob >> 9) & 1) << 5)); }
__host__ __device__ __forceinline__ void stage_rc(int b, int& R, int& C) { const int st = b / 1024, sb = b % 1024, swz = sb ^ (((sb >> 9) & 1) << 5); R = (st >> 1) * 16 + swz / 64; C = (st & 1) * 32 + (swz % 64) / 2; }
__host__ __device__ __forceinline__ int perm32(int rho) { const int n = rho >> 4, i = rho & 15; return 8 * (i >> 2) + 4 * n + (i & 3); }
struct Unit { int pm, pn; };
struct Gemm { const bf16_t* A; const bf16_t* Bt; int M, N, K; };
struct StaticOrder {
    int nM, nN, nwg, G, c;
    __host__ __device__ void init(int M, int N, int G_, int c_) { nM = M / BM; nN = N / BM; nwg = nM * nN; G = G_; c = c_; }
    __host__ __device__ bool next(int i, Unit& u) const {
        const long L = (long)i * G + c; if (L >= nwg) return false;
        int wgid = (int)L; { const int q = nwg / NXCD, r = nwg % NXCD, xcd = wgid % NXCD, off = wgid / NXCD; wgid = (xcd < r ? xcd * (q + 1) : r * (q + 1) + (xcd - r) * q) + off; }
        const int nig = WGM * nN, gid = wgid / nig, fm = gid * WGM, gsz = (nM - fm) < WGM ? (nM - fm) : WGM;
        u.pm = fm + ((wgid % nig) % gsz); u.pn = (wgid % nig) / gsz; return true;
    }
    __device__ __forceinline__ void a_ready(const Unit&) const {}
    __device__ __forceinline__ void done(const Unit&) const {}
};
template <class Epi, class Sched, bool ALIGN_EPI = false, bool SP2 = false>
__device__ __forceinline__ void gemm_phase(PG8_LAS unsigned char* lds, const Gemm g, const Sched& S, const Epi& E) {
    const int tid = otid(), wid = __builtin_amdgcn_readfirstlane(tid >> 6), lane = tid & 63, wr = wid >> 2, wc = wid & 3, fr = lane & 15, fq = lane >> 4;
    const int K = g.K, nt = K / BK;
    unsigned voffA[2], voffB[2];
#pragma unroll
    for (int i = 0; i < 2; ++i) { int R, C; stage_rc(tid * 16 + i * 8192, R, C); const int Rb = Epi::PERM ? ((R & ~31) + perm32(R & 31)) : R;
        voffA[i] = (unsigned)(R * K + C) * 2u; voffB[i] = (unsigned)(Rb * K + C) * 2u; }
    const size_t kstep = (size_t)(BK * 2);
    const size_t hstep = (size_t)HALF * K * 2;
    const size_t tstep = 2 * hstep;
    const unsigned ldsw = (unsigned)wid * 1024u;
    const int aoff = lds_byte(wr * 64 + fr, fq * 8), boff = lds_byte(wc * 32 + fr, fq * 8);
#define PG8_SA(b, h) (((b) * 2 + (h)) * HTB)
#define PG8_SB(b, h) ((4 + (b) * 2 + (h)) * HTB)
#define PG8_STAGE(bufoff, gbase, voff) do { _Pragma("unroll") for (int _i = 0; _i < 2; ++_i) \
        __builtin_amdgcn_global_load_lds((const unsigned*)((const char*)(gbase) + (voff)[_i]), (PG8_LAS unsigned*)(lds + (bufoff) + ldsw + _i * 8192), 16, 0, 0); } while (0)
#define PG8_LDA(dst, b, h) do { _Pragma("unroll") for (int m = 0; m < 4; ++m) _Pragma("unroll") for (int k = 0; k < 2; ++k) dst[m][k] = *(const PG8_LAS bf16x8*)(lds + PG8_SA(b, h) + aoff + m * 2048 + k * 1024); } while (0)
#define PG8_LDB(dst, b, h) do { _Pragma("unroll") for (int n = 0; n < 2; ++n) _Pragma("unroll") for (int k = 0; k < 2; ++k) dst[n][k] = *(const PG8_LAS bf16x8*)(lds + PG8_SB(b, h) + boff + n * 2048 + k * 1024); } while (0)
#define PG8_MMA(ai, bj, At, Bt) do { __builtin_amdgcn_s_setprio(1); _Pragma("unroll") for (int m = 0; m < 4; ++m) _Pragma("unroll") for (int n = 0; n < 2; ++n) _Pragma("unroll") for (int k = 0; k < 2; ++k) \
        acc[ai][bj][m][n] = __builtin_amdgcn_mfma_f32_16x16x32_bf16(Bt[n][k], At[m][k], acc[ai][bj][m][n], 0, 0, 0); __builtin_amdgcn_s_setprio(0); } while (0)
#define PG8_WAIT_V(n) asm volatile("s_waitcnt vmcnt(" #n ")" ::: "memory")
#define PG8_WAIT_L(n) asm volatile("s_waitcnt lgkmcnt(" #n ")" ::: "memory")
#define PG8_BAR __builtin_amdgcn_s_barrier()
#define PG8_SCHED __builtin_amdgcn_sched_barrier(0)
    Unit cur, nxt; int ui = 0;
    if (!S.next(0, cur)) return;
    f32x4 acc[2][2][4][2];
#pragma unroll
    for (int a = 0; a < 2; ++a)
#pragma unroll
        for (int b = 0; b < 2; ++b)
#pragma unroll
            for (int m = 0; m < 4; ++m)
#pragma unroll
                for (int n = 0; n < 2; ++n) acc[a][b][m][n] = (f32x4){0.f, 0.f, 0.f, 0.f};
    bf16x8 At[4][2], B0[2][2], B1[2][2];
    const char* cA = (const char*)g.A + (size_t)cur.pm * tstep; const char* cB = (const char*)g.Bt + (size_t)cur.pn * tstep;
    S.a_ready(cur);
    if constexpr (SP2) {
        PG8_STAGE(PG8_SB(0, 0), cB, voffB); PG8_STAGE(PG8_SB(0, 1), cB + hstep, voffB); PG8_STAGE(PG8_SA(0, 0), cA, voffA); PG8_STAGE(PG8_SA(0, 1), cA + hstep, voffA);
        if (wr == 1) PG8_BAR;
        PG8_WAIT_V(2); PG8_BAR;
        PG8_STAGE(PG8_SB(1, 0), cB + kstep, voffB); PG8_STAGE(PG8_SA(1, 0), cA + kstep, voffA); PG8_STAGE(PG8_SB(1, 1), cB + hstep + kstep, voffB);
        PG8_WAIT_V(6); PG8_BAR;
    } else {
        PG8_STAGE(PG8_SB(0, 0), cB, voffB); PG8_STAGE(PG8_SA(0, 0), cA, voffA); PG8_STAGE(PG8_SB(0, 1), cB + hstep, voffB); PG8_STAGE(PG8_SA(0, 1), cA + hstep, voffA);
        if (wr == 1) PG8_BAR;
        PG8_WAIT_V(4); PG8_BAR;
        PG8_STAGE(PG8_SB(1, 0), cB + kstep, voffB); PG8_STAGE(PG8_SA(1, 0), cA + kstep, voffA); PG8_STAGE(PG8_SB(1, 1), cB + hstep + kstep, voffB);
        PG8_WAIT_V(6); PG8_BAR;
    }
    for (;;) {
        const bool has_next = S.next(ui + 1, nxt);
        const char* nA = has_next ? (const char*)g.A + (size_t)nxt.pm * tstep : cA; const char* nB = has_next ? (const char*)g.Bt + (size_t)nxt.pn * tstep : cB;
        for (int t = 0; t < nt; t += 2) {
            const bool last = (t == nt - 2);
            const char* a1 = cA + (size_t)(t + 1) * kstep;
            const char* a2 = last ? nA : cA + (size_t)(t + 2) * kstep; const char* b2 = last ? nB : cB + (size_t)(t + 2) * kstep;
            const char* a3 = a2 + kstep; const char* b3 = b2 + kstep;
            if constexpr (Epi::MIDK) { if (t == (nt >> 1)) E.mid(acc, cur, wr, wc, fr, fq); }
            if (last && has_next) S.a_ready(nxt);
            if constexpr (SP2) {
            PG8_LDB(B0, 0, 0); PG8_LDB(B1, 0, 1); PG8_SCHED; PG8_LDA(At, 0, 0); PG8_STAGE(PG8_SA(1, 1), a1 + hstep, voffA);
            PG8_WAIT_V(8); PG8_WAIT_L(0); PG8_BAR; PG8_MMA(0, 0, At, B0); PG8_MMA(0, 1, At, B1); PG8_BAR; PG8_SCHED;
            PG8_LDA(At, 0, 1); PG8_STAGE(PG8_SB(0, 0), b2, voffB); PG8_STAGE(PG8_SB(0, 1), b2 + hstep, voffB); PG8_STAGE(PG8_SA(0, 0), a2, voffA);
            PG8_WAIT_V(8); PG8_WAIT_L(0); PG8_BAR; PG8_MMA(1, 0, At, B0); PG8_MMA(1, 1, At, B1); PG8_BAR; PG8_SCHED;
            PG8_LDB(B0, 1, 0); PG8_LDB(B1, 1, 1); PG8_SCHED; PG8_LDA(At, 1, 0); PG8_STAGE(PG8_SA(0, 1), a2 + hstep, voffA);
            PG8_WAIT_V(8); PG8_WAIT_L(0); PG8_BAR; PG8_MMA(0, 0, At, B0); PG8_MMA(0, 1, At, B1); PG8_BAR; PG8_SCHED;
            PG8_LDA(At, 1, 1); PG8_STAGE(PG8_SB(1, 0), b3, voffB); PG8_STAGE(PG8_SB(1, 1), b3 + hstep, voffB); PG8_STAGE(PG8_SA(1, 0), a3, voffA);
            PG8_WAIT_V(8); PG8_WAIT_L(0); PG8_BAR; PG8_MMA(1, 0, At, B0); PG8_MMA(1, 1, At, B1); PG8_BAR; PG8_SCHED;
            } else {
            PG8_LDB(B0, 0, 0); PG8_SCHED; PG8_LDA(At, 0, 0); PG8_STAGE(PG8_SA(1, 1), a1 + hstep, voffA);
            PG8_WAIT_L(8); PG8_BAR; PG8_WAIT_L(0); PG8_MMA(0, 0, At, B0); PG8_BAR; PG8_SCHED;
            PG8_LDB(B1, 0, 1); PG8_STAGE(PG8_SB(0, 0), b2, voffB);
            PG8_BAR; PG8_WAIT_L(0); PG8_MMA(0, 1, At, B1); PG8_BAR;
            PG8_LDA(At, 0, 1); PG8_STAGE(PG8_SA(0, 0), a2, voffA);
            PG8_BAR; PG8_WAIT_L(0); PG8_MMA(1, 0, At, B0); PG8_BAR; PG8_SCHED;
            PG8_STAGE(PG8_SB(0, 1), b2 + hstep, voffB);
            PG8_WAIT_V(6); PG8_BAR; PG8_MMA(1, 1, At, B1); PG8_BAR;
            PG8_LDB(B0, 1, 0); PG8_SCHED; PG8_LDA(At, 1, 0); PG8_STAGE(PG8_SA(0, 1), a2 + hstep, voffA);
            PG8_WAIT_L(8); PG8_BAR; PG8_WAIT_L(0); PG8_MMA(0, 0, At, B0); PG8_BAR; PG8_SCHED;
            PG8_LDB(B1, 1, 1); PG8_STAGE(PG8_SB(1, 0), b3, voffB);
            PG8_BAR; PG8_WAIT_L(0); PG8_MMA(0, 1, At, B1); PG8_BAR;
            PG8_LDA(At, 1, 1); PG8_STAGE(PG8_SA(1, 0), a3, voffA);
            PG8_BAR; PG8_WAIT_L(0); PG8_MMA(1, 0, At, B0); PG8_BAR; PG8_SCHED;
            PG8_STAGE(PG8_SB(1, 1), b3 + hstep, voffB);
            PG8_WAIT_V(6); PG8_BAR; PG8_MMA(1, 1, At, B1); PG8_BAR;
            }
        }
        if constexpr (ALIGN_EPI) { if (wr == 0) PG8_BAR; }
        if constexpr (!Epi::AFTER_DRAIN) { E(acc, cur, wr, wc, fr, fq); S.done(cur); }
        if (!has_next) break;
#pragma unroll
        for (int a = 0; a < 2; ++a)
#pragma unroll
            for (int b = 0; b < 2; ++b)
#pragma unroll
                for (int m = 0; m < 4; ++m)
#pragma unroll
                    for (int n = 0; n < 2; ++n) acc[a][b][m][n] = (f32x4){0.f, 0.f, 0.f, 0.f};
        cur = nxt; cA = nA; cB = nB; ++ui;
        if constexpr (ALIGN_EPI) { if (wr == 1) PG8_BAR; }
    }
    PG8_WAIT_V(0);
    if constexpr (!ALIGN_EPI) { if (wr == 0) PG8_BAR; }
    PG8_BAR;
    if constexpr (Epi::AFTER_DRAIN) { E.fused(acc, cur, wr, wc, fr, fq, lds, wid, lane); S.done(cur); }
#undef PG8_SA
#undef PG8_SB
#undef PG8_STAGE
#undef PG8_LDA
#undef PG8_LDB
#undef PG8_MMA
#undef PG8_WAIT_V
#undef PG8_WAIT_L
#undef PG8_BAR
#undef PG8_SCHED
}
}

#define LAS __attribute__((address_space(3)))
typedef unsigned short bf16_t;
typedef short bf16x8 __attribute__((ext_vector_type(8)));
typedef short bf16x4 __attribute__((ext_vector_type(4)));
typedef float f32x4 __attribute__((ext_vector_type(4)));
typedef unsigned u32x4 __attribute__((ext_vector_type(4)));
typedef unsigned u32x2 __attribute__((ext_vector_type(2)));

constexpr int NT = 512;
constexpr int D = 1024, TOKL = 16384, TOKC = 2048, TOK = TOKL + TOKC, SEQ = 2048, CTXL = 256, FF = 2816;
constexpr int IN_COLS = 9248;
constexpr int N1A = 3328, N1B = 6144;
constexpr float EPS = 1e-6f;
constexpr size_t KiB = 1024, MiB = 1024 * 1024;
constexpr size_t OFF_WIN = 0, OFF_WM = 18 * MiB + 512 * KiB, OFF_WC = OFF_WM + 2 * MiB, OFF_WO = OFF_WC + 2 * MiB, OFF_WUP = OFF_WO + 2 * MiB,
                 OFF_WDN = OFF_WUP + 11 * MiB, OFF_MOD = 41 * MiB, OFF_GATES = 41 * MiB + 512 * KiB,
                 OFF_AH = 44 * MiB, OFF_QKV = 80 * MiB, SZ_TOK = (size_t)TOK * D * 2  , OFF_V = OFF_QKV + 2 * SZ_TOK, OFF_K = 188 * MiB,
                 OFF_HF = 80 * MiB, OFF_HB = 112 * MiB, OFF_O = 144 * MiB, OFF_SB = 176 * MiB, OFF_U = 208 * MiB,
                 OFF_T = 80 * MiB, OFF_Z = 44 * MiB, OFF_HX2 = 224 * MiB, OFF_A = 44 * MiB, OFF_G = 132 * MiB, WS_NEED = 256 * MiB;
constexpr int LDS_BYTES = 152 * 1024;
constexpr size_t OFF_HCTR = 41 * MiB + 256 * KiB + 32 * KiB;

struct Params {
    const float *x, *c, *ctx, *c_ctx, *ada_w, *ada_b, *norm1_g, *norm2_g, *w_in, *qk_conv_w, *qk_conv_b, *gate_b, *mnorm_g, *w_m_out,
                *sc_conv_w, *sc_conv_b, *w_c_out, *w_o, *w_up, *ff_conv_w, *ff_conv_b, *w_down, *final_g;
    float* out; unsigned char* ws;
};

typedef __bf16 bf16v2_t __attribute__((ext_vector_type(2)));
typedef float f32v2_t __attribute__((ext_vector_type(2)));
__device__ __forceinline__ unsigned pk2(float lo, float hi) { const f32v2_t f = {lo, hi}; const bf16v2_t b = __builtin_convertvector(f, bf16v2_t); return __builtin_bit_cast(unsigned, b); }
__device__ __forceinline__ float bflo(unsigned w) { return __uint_as_float(w << 16); }
__device__ __forceinline__ float bfhi(unsigned w) { return __uint_as_float(w & 0xffff0000u); }
__device__ __forceinline__ void unpack8(const u32x4 w, float (&f)[8]) { f[0] = bflo(w.x); f[1] = bfhi(w.x); f[2] = bflo(w.y); f[3] = bfhi(w.y); f[4] = bflo(w.z); f[5] = bfhi(w.z); f[6] = bflo(w.w); f[7] = bfhi(w.w); }
__device__ __forceinline__ u32x4 pack8(const float (&f)[8]) { u32x4 w; w.x = pk2(f[0], f[1]); w.y = pk2(f[2], f[3]); w.z = pk2(f[4], f[5]); w.w = pk2(f[6], f[7]); return w; }
__device__ __forceinline__ float sigmoidf_(float v) { return __builtin_amdgcn_rcpf(1.0f + __expf(-v)); }
__device__ __forceinline__ float wave_sum(float v) {
#pragma unroll
    for (int o = 1; o < 64; o <<= 1) v += __shfl_xor(v, o);
    return v;
}
#define LDS_WAIT() asm volatile("s_waitcnt lgkmcnt(0)" ::: "memory")

__device__ __forceinline__ int win_row(int c) {
    if (c < 3104) return c;
    if (c < 5152) return N1A + (c - 3104);
    if (c < 6176) { const int i = (c - 5152) >> 7, r = (c - 5152) & 127; return N1A + 2048 + i * 256 + r; }
    if (c < 7200) { const int i = (c - 6176) >> 7, r = (c - 6176) & 127; return N1A + 2048 + i * 256 + 128 + r; }
    return N1A + 4096 + (c - 7200);
}
struct TrItem { const float* W; bf16_t* WT; int N, k0, n0, pitch, koff; bool win; };
constexpr int TI_NB_IN = (IN_COLS + 255) / 256, TI_IN = 16 * TI_NB_IN, TI_SQ = 16 * 4, TI_UP = 16 * (2 * FF / 256), TI_DN = (FF / 64) * 4, TI_ALL = TI_IN + 3 * TI_SQ + TI_UP + TI_DN;
__device__ __forceinline__ bool tr_decode(const Params& p, int it, TrItem& t) {
    if (it >= TI_ALL) return false;
    int r = it; t.win = false; t.koff = 0; t.pitch = D;
    if (r < TI_IN) { t.W = p.w_in; t.WT = (bf16_t*)(p.ws + OFF_WIN); t.N = IN_COLS; t.k0 = (r / TI_NB_IN) * 64; t.n0 = (r % TI_NB_IN) * 256; t.win = true; return true; } r -= TI_IN;
    if (r < TI_SQ) { t.W = p.w_m_out; t.WT = (bf16_t*)(p.ws + OFF_WM); t.N = D; t.k0 = (r >> 2) * 64; t.n0 = (r & 3) * 256; t.pitch = 2 * D; return true; } r -= TI_SQ;
    if (r < TI_SQ) { t.W = p.w_c_out; t.WT = (bf16_t*)(p.ws + OFF_WM); t.N = D; t.k0 = (r >> 2) * 64; t.n0 = (r & 3) * 256; t.pitch = 2 * D; t.koff = D; return true; } r -= TI_SQ;
    if (r < TI_SQ) { t.W = p.w_o; t.WT = (bf16_t*)(p.ws + OFF_WO); t.N = D; t.k0 = (r >> 2) * 64; t.n0 = (r & 3) * 256; return true; } r -= TI_SQ;
    if (r < TI_UP) { t.W = p.w_up; t.WT = (bf16_t*)(p.ws + OFF_WUP); t.N = 2 * FF; t.k0 = (r / (2 * FF / 256)) * 64; t.n0 = (r % (2 * FF / 256)) * 256; return true; } r -= TI_UP;
    t.W = p.w_down; t.WT = (bf16_t*)(p.ws + OFF_WDN); t.N = D; t.k0 = (r >> 2) * 64; t.n0 = (r & 3) * 256; t.pitch = FF; return true;
}
__device__ __forceinline__ void tr_load(const TrItem& t, f32x4 (&v)[8], int wave, int lane) {
    const int n = t.n0 + 4 * lane; const bool ok = n < t.N;
    const float* src = t.W + (size_t)(t.k0 + wave) * t.N + n;
#pragma unroll
    for (int i = 0; i < 8; ++i) v[i] = ok ? *(const f32x4*)(src + (size_t)(8 * i) * t.N) : (f32x4){0.f, 0.f, 0.f, 0.f};
}
__device__ __forceinline__ void phase0(const Params& p, LAS unsigned char* lds) {
    const int tid = otid(), lane = tid & 63, wave = tid >> 6;
    LAS float* sc = (LAS float*)lds;
    LAS float* part = (LAS float*)(lds + 8192);
    float* mod = (float*)(p.ws + OFF_MOD);
    for (int item = blockIdx.x; item < 192; item += gridDim.x) {
        const int cg = item % 24, ksl = item / 24;
        for (int i = tid; i < 9 * 128; i += NT) { const int r = i >> 7, k = ksl * 128 + (i & 127); const float v = r < 8 ? p.c[r * 1024 + k] : p.c_ctx[k]; sc[i] = v / (1.0f + __expf(-v)); }
        __syncthreads();
        f32x4 acc[9];
#pragma unroll
        for (int r = 0; r < 9; ++r) acc[r] = (f32x4){0.f, 0.f, 0.f, 0.f};
        const float* src = p.ada_w + (size_t)(ksl * 128 + wave) * 6144 + cg * 256 + 4 * lane;
        f32x4 wv[16];
#pragma unroll
        for (int i = 0; i < 16; ++i) wv[i] = *(const f32x4*)(src + (size_t)(8 * i) * 6144);
#pragma unroll
        for (int i = 0; i < 16; ++i) {
#pragma unroll
            for (int r = 0; r < 9; ++r) acc[r] += wv[i] * sc[r * 128 + wave + 8 * i]; }
#pragma unroll
        for (int r = 0; r < 9; ++r) *(LAS f32x4*)(part + (wave * 9 + r) * 256 + 4 * lane) = acc[r];
        __syncthreads();
        for (int o = tid; o < 9 * 256; o += NT) { const int r = o >> 8, cc = o & 255; float sum = ksl == 0 ? p.ada_b[cg * 256 + cc] : 0.f;
#pragma unroll
            for (int q = 0; q < 8; ++q) sum += part[(q * 9 + r) * 256 + cc];
            (void)__hip_atomic_fetch_add(mod + r * 6144 + cg * 256 + cc, sum, __ATOMIC_RELAXED, __HIP_MEMORY_SCOPE_AGENT); }
        asm volatile("s_waitcnt vmcnt(0)" ::: "memory");
        __syncthreads();
        if (tid == 0) (void)__hip_atomic_fetch_add((unsigned*)(p.ws + OFF_HCTR), 1u, __ATOMIC_RELAXED, __HIP_MEMORY_SCOPE_AGENT);
    }
    { u32x4* z = (u32x4*)(p.ws + OFF_WIN + (size_t)3104 * D * 2); const int n16 = 224 * D * 2 / 16;
      for (int i = blockIdx.x * NT + tid; i < n16; i += gridDim.x * NT) z[i] = (u32x4){0u, 0u, 0u, 0u}; }
    LAS float* tile = (LAS float*)lds;
    const int G = (int)gridDim.x;
    TrItem cur, nxt; f32x4 v[8];
    int it = G - 1 - (int)blockIdx.x;
    bool have = tr_decode(p, it, cur);
    if (have) tr_load(cur, v, wave, lane);
    while (have) {
#pragma unroll
        for (int i = 0; i < 8; ++i) { LAS float* q = tile + (wave + 8 * i) * 257 + 4 * lane; q[0] = v[i][0]; q[1] = v[i][1]; q[2] = v[i][2]; q[3] = v[i][3]; }
        __syncthreads();
        it += G;
        const bool more = tr_decode(p, it, nxt);
        if (more) tr_load(nxt, v, wave, lane);
#pragma unroll
        for (int j = 0; j < 4; ++j) { const int c = tid + NT * j, n = c >> 3, kc = c & 7, ng = cur.n0 + n;
            if (ng < cur.N) { const LAS float* q = tile + (kc * 8) * 257 + n;
                u32x4 o; o.x = pk2(q[0], q[257]); o.y = pk2(q[2 * 257], q[3 * 257]); o.z = pk2(q[4 * 257], q[5 * 257]); o.w = pk2(q[6 * 257], q[7 * 257]);
                const int drow = cur.win ? win_row(ng & ~31) + (ng & 31) : ng;
                *(u32x4*)(cur.WT + (size_t)drow * cur.pitch + cur.koff + cur.k0 + kc * 8) = o; } }
        __syncthreads();
        cur = nxt; have = more;
    }
}

__device__ __forceinline__ void modnorm_rows4(const float* xrow, const float* g, const float* shift, const float* scale, bf16_t* orow, int lane) {
    f32x4 v[4][4]; float s[4];
#pragma unroll
    for (int r = 0; r < 4; ++r)
#pragma unroll
        for (int j = 0; j < 4; ++j) v[r][j] = ((const f32x4*)(xrow + (size_t)r * D))[lane + 64 * j];
#pragma unroll
    for (int r = 0; r < 4; ++r) { float a = 0.f;
#pragma unroll
        for (int j = 0; j < 4; ++j) a += (v[r][j].x * v[r][j].x + v[r][j].y * v[r][j].y) + (v[r][j].z * v[r][j].z + v[r][j].w * v[r][j].w);
        s[r] = a; }
#pragma unroll
    for (int o = 1; o < 64; o <<= 1) {
#pragma unroll
        for (int r = 0; r < 4; ++r) s[r] += __shfl_xor(s[r], o); }
#pragma unroll
    for (int j = 0; j < 4; ++j) { const int cidx = lane + 64 * j; const f32x4 gg = ((const f32x4*)g)[cidx], sh = ((const f32x4*)shift)[cidx], sc = ((const f32x4*)scale)[cidx]; const f32x4 gs = gg * (sc + 1.0f);
#pragma unroll
        for (int r = 0; r < 4; ++r) { const float rstd = rsqrtf(s[r] * (1.0f / D) + EPS); const f32x4 y = v[r][j] * rstd * gs + sh; u32x2 w; w.x = pk2(y.x, y.y); w.y = pk2(y.z, y.w); ((u32x2*)(orow + (size_t)r * D))[cidx] = w; } }
}
__device__ __forceinline__ void phase1(const Params& p) {
    const int tid_ = otid(), lane = tid_ & 63, gw = blockIdx.x * 8 + (tid_ >> 6), ngw = gridDim.x * 8;
    const float* mod = (const float*)(p.ws + OFF_MOD); bf16_t* ah = (bf16_t*)(p.ws + OFF_AH);
    for (int row = gw * 4; row < TOK; row += ngw * 4) {
        const float* src = row < TOKC ? p.ctx + (size_t)row * D : p.x + (size_t)(row - TOKC) * D;
        const int mi = row < TOKC ? 8 : (row - TOKC) >> 11;
        modnorm_rows4(src, p.norm1_g, mod + mi * 6144, mod + mi * 6144 + 1024, ah + (size_t)row * D, lane);
    }
}
constexpr size_t OFF_BAR = 41 * MiB + 256 * KiB, OFF_RS = OFF_BAR + 64 * KiB, ZERO_BYTES = 192 * KiB;

#define XB_TMO      128
#define XB_XCNT(j)  (256  + 64 * (j))
#define XB_XSUB(j)  (1280 + 64 * (j))
#define XB_XGEN(j)  (2304 + 64 * (j))
#define XB_TOP      3328
#define XB_TOPGEN   3392
#define XCD_BAR_WORDS 3456
#define XB_SPIN_CAP (1u << 18)

__device__ __forceinline__ unsigned xb_ld(unsigned* p)              { return __hip_atomic_load(p, __ATOMIC_RELAXED, __HIP_MEMORY_SCOPE_AGENT); }
__device__ __forceinline__ unsigned xb_add(unsigned* p, unsigned v) { return __hip_atomic_fetch_add(p, v, __ATOMIC_RELAXED, __HIP_MEMORY_SCOPE_AGENT); }
__device__ __forceinline__ unsigned xb_xcc_id() { return (unsigned)__builtin_amdgcn_s_getreg((3 << 11) | 20) & 0xFu; }
#define XB_SPIN(cond, bar) do { unsigned _sp = 0; while (cond) { __builtin_amdgcn_s_sleep(1); \
    if ((++_sp & 255u) == 0u) { if (xb_ld(&(bar)[XB_TMO])) break; if (_sp > XB_SPIN_CAP) { atomicAdd(&(bar)[XB_TMO], 1u); break; } } } } while (0)

struct XcdBarrier {
    unsigned* bar; unsigned x;
    volatile LAS unsigned* st;
};

__device__ __forceinline__ XcdBarrier xcd_barrier_post(unsigned* bar, volatile LAS unsigned* st) {
    XcdBarrier b; b.bar = bar; b.x = xb_xcc_id(); b.st = st;
    if (threadIdx.x == 0) (void)xb_add(&bar[XB_XCNT(b.x)], 1u);
    return b;
}
__device__ __forceinline__ void xcd_barrier_complete(unsigned* bar, unsigned x, unsigned& nloc, unsigned& nx) {
    const unsigned G = gridDim.x * gridDim.y * gridDim.z;
    unsigned sum, cnt, mine, sp = 0u;
    for (;;) {
        sum = 0u; cnt = 0u; mine = 0u;
#pragma unroll
        for (unsigned j = 0; j < 16; ++j) { const unsigned c = xb_ld(&bar[XB_XCNT(j)]); sum += c; cnt += (c > 0u) ? 1u : 0u; mine = (j == x) ? c : mine; }
        if (sum == G) break;
        __builtin_amdgcn_s_sleep(1);
        if ((++sp & 255u) == 0u) { if (xb_ld(&bar[XB_TMO])) break; if (sp > XB_SPIN_CAP) { atomicAdd(&bar[XB_TMO], 1u); break; } }
    }
    nloc = mine > 0u ? mine : 1u; nx = cnt > 0u ? cnt : 1u;
}

__device__ __forceinline__ void xcd_barrier(const XcdBarrier& b) {
    asm volatile("s_waitcnt vmcnt(0)" ::: "memory");
    __syncthreads();
    if (threadIdx.x == 0) {
        unsigned* bar = b.bar;
        __builtin_amdgcn_s_waitcnt(0);
        unsigned nloc = b.st[0], nx = b.st[1];
        if (nloc == 0u) { xcd_barrier_complete(bar, b.x, nloc, nx); b.st[0] = nloc; b.st[1] = nx; }
        const unsigned old = xb_add(&bar[XB_XSUB(b.x)], 1u);
        const unsigned gen = old / nloc;
        if (old + 1u == (gen + 1u) * nloc) {
            __builtin_amdgcn_fence(__ATOMIC_RELEASE, "agent");
            asm volatile("s_waitcnt vmcnt(0)" ::: "memory");
            const unsigned og = xb_add(&bar[XB_TOP], 1u);
            const unsigned tg = og / nx;
            if (og + 1u == (tg + 1u) * nx) xb_add(&bar[XB_TOPGEN], 1u);
            else XB_SPIN(xb_ld(&bar[XB_TOPGEN]) == tg, bar);
            __builtin_amdgcn_fence(__ATOMIC_ACQUIRE, "agent");
            xb_add(&bar[XB_XGEN(b.x)], 1u);
            asm volatile("s_waitcnt vmcnt(0)" ::: "memory");
        } else {
            XB_SPIN(xb_ld(&bar[XB_XGEN(b.x)]) == gen, bar);
            __builtin_amdgcn_fence(__ATOMIC_ACQUIRE, "agent");
            asm volatile("s_waitcnt vmcnt(0)" ::: "memory");
        }
    }
    __syncthreads();
}


__device__ __forceinline__ void xcd_barrier_nofence(const XcdBarrier& b) {
    asm volatile("s_waitcnt vmcnt(0)" ::: "memory");
    __syncthreads();
    if (threadIdx.x == 0) {
        unsigned* bar = b.bar;
        __builtin_amdgcn_s_waitcnt(0);
        unsigned nloc = b.st[0], nx = b.st[1];
        if (nloc == 0u) { xcd_barrier_complete(bar, b.x, nloc, nx); b.st[0] = nloc; b.st[1] = nx; }
        const unsigned old = xb_add(&bar[XB_XSUB(b.x)], 1u);
        const unsigned gen = old / nloc;
        if (old + 1u == (gen + 1u) * nloc) {
            asm volatile("s_waitcnt vmcnt(0)" ::: "memory");
            const unsigned og = xb_add(&bar[XB_TOP], 1u);
            const unsigned tg = og / nx;
            if (og + 1u == (tg + 1u) * nx) xb_add(&bar[XB_TOPGEN], 1u);
            else XB_SPIN(xb_ld(&bar[XB_TOPGEN]) == tg, bar);
            xb_add(&bar[XB_XGEN(b.x)], 1u);
            asm volatile("s_waitcnt vmcnt(0)" ::: "memory");
        } else {
            XB_SPIN(xb_ld(&bar[XB_XGEN(b.x)]) == gen, bar);
            asm volatile("s_waitcnt vmcnt(0)" ::: "memory");
        }
    }
    __syncthreads();
}
using pg8::Unit;
__device__ __forceinline__ void st8(bf16_t* q, const f32x4 a, const f32x4 b) { u32x4 w; w.x = pk2(a[0], a[1]); w.y = pk2(a[2], a[3]); w.z = pk2(b[0], b[1]); w.w = pk2(b[2], b[3]); *(u32x4*)q = w; }
__device__ __forceinline__ f32x4 sig4(const f32x4 a) { f32x4 r; r[0] = sigmoidf_(a[0]); r[1] = sigmoidf_(a[1]); r[2] = sigmoidf_(a[2]); r[3] = sigmoidf_(a[3]); return r; }

struct Epi1a {
    static constexpr bool PERM = true, AFTER_DRAIN = false, MIDK = false;
    bf16_t* qkv; float* gates; const float* gate_b;
    __device__ __forceinline__ void operator()(const f32x4 (&acc)[2][2][4][2], const Unit& u, int wr, int wc, int fr, int fq) const {
        const int row0 = u.pm * 256 + wr * 64 + fr;
        if (u.pn < 12) {
            bf16_t* base = qkv + (size_t)(u.pn >> 2) * ((size_t)TOK * D) + (u.pn & 3) * 256 + wc * 32 + 8 * fq;
#pragma unroll
            for (int ai = 0; ai < 2; ++ai)
#pragma unroll
                for (int m = 0; m < 4; ++m) { bf16_t* rowp = base + (size_t)(row0 + ai * 128 + m * 16) * D;
#pragma unroll
                    for (int bj = 0; bj < 2; ++bj) st8(rowp + bj * 128, acc[ai][bj][m][0], acc[ai][bj][m][1]); }
        } else if (wc == 0) {
            const f32x4 b0 = *(const f32x4*)(gate_b + 8 * fq), b1 = *(const f32x4*)(gate_b + 8 * fq + 4);
#pragma unroll
            for (int ai = 0; ai < 2; ++ai)
#pragma unroll
                for (int m = 0; m < 4; ++m) { float* rowp = gates + (size_t)(row0 + ai * 128 + m * 16) * 32 + 8 * fq;
                    *(f32x4*)rowp = acc[ai][0][m][0] + b0; *(f32x4*)(rowp + 4) = acc[ai][0][m][1] + b1; }
        }
    }
};
struct Epi1b {
    static constexpr bool PERM = true, AFTER_DRAIN = false, MIDK = false;
    bf16_t *osb, *uu, *gmc;
    __device__ __forceinline__ void operator()(const f32x4 (&acc)[2][2][4][2], const Unit& u, int wr, int wc, int fr, int fq) const {
        const int row0 = u.pm * 256 + wr * 64 + fr, cl = wc * 32 + 8 * fq;
        if (u.pn >= 8 && u.pn < 16) {
            bf16_t* base = uu + (size_t)row0 * D + (u.pn - 8) * 128 + cl;
#pragma unroll
            for (int ai = 0; ai < 2; ++ai)
#pragma unroll
                for (int m = 0; m < 4; ++m) st8(base + (size_t)(ai * 128 + m * 16) * D, acc[ai][0][m][0] * acc[ai][1][m][0], acc[ai][0][m][1] * acc[ai][1][m][1]);
        } else {
            const int q = u.pn & 7;
            const int ld = u.pn < 8 ? 2 * D : D;
            bf16_t* base = u.pn < 8 ? osb + (size_t)row0 * ld + q * 256 + cl : gmc + (size_t)(q >> 2) * ((size_t)TOKL * D) + (size_t)row0 * D + (q & 3) * 256 + cl;
            if (u.pn >= 4 && u.pn < 8) {
#pragma unroll
                for (int ai = 0; ai < 2; ++ai)
#pragma unroll
                    for (int m = 0; m < 4; ++m)
#pragma unroll
                        for (int bj = 0; bj < 2; ++bj) st8(base + (size_t)(ai * 128 + m * 16) * ld + bj * 128, acc[ai][bj][m][0], acc[ai][bj][m][1]);
            } else {
#pragma unroll
                for (int ai = 0; ai < 2; ++ai)
#pragma unroll
                    for (int m = 0; m < 4; ++m)
#pragma unroll
                        for (int bj = 0; bj < 2; ++bj) st8(base + (size_t)(ai * 128 + m * 16) * ld + bj * 128, sig4(acc[ai][bj][m][0]), sig4(acc[ai][bj][m][1]));
            }
        }
    }
};
__device__ __forceinline__ f32x4 ld4bf(const bf16_t* q) { const u32x2 w = *(const u32x2*)q; f32x4 r; r[0] = bflo(w.x); r[1] = bfhi(w.x); r[2] = bflo(w.y); r[3] = bfhi(w.y); return r; }
struct EpiUp {
    static constexpr bool PERM = true, AFTER_DRAIN = false, MIDK = false;
    bf16_t *a, *g;
    __device__ __forceinline__ void operator()(const f32x4 (&acc)[2][2][4][2], const Unit& u, int wr, int wc, int fr, int fq) const {
        const int row0 = u.pm * 256 + wr * 64 + fr;
        bf16_t* base = (u.pn < 11 ? a + u.pn * 256 : g + (u.pn - 11) * 256) + wc * 32 + 8 * fq;
#pragma unroll
        for (int ai = 0; ai < 2; ++ai)
#pragma unroll
            for (int m = 0; m < 4; ++m) { bf16_t* rowp = base + (size_t)(row0 + ai * 128 + m * 16) * FF;
#pragma unroll
                for (int bj = 0; bj < 2; ++bj) st8(rowp + bj * 128, acc[ai][bj][m][0], acc[ai][bj][m][1]); }
    }
};
struct EpiMerge2 {
    static constexpr bool PERM = false, AFTER_DRAIN = false, MIDK = true;
    const bf16_t *gm, *gc; bf16_t* z;
    __device__ __forceinline__ void mid(f32x4 (&acc)[2][2][4][2], const Unit& u, int wr, int wc, int fr, int fq) const {
        int opq = 0; asm volatile("" : "+v"(opq));
        const int row0 = u.pm * 256 + wr * 64 + fr + opq, col0 = u.pn * 256 + wc * 32 + 4 * fq;
#pragma unroll
        for (int ai = 0; ai < 2; ++ai) { u32x2 ga[4][2][2], gb[4][2][2];
#pragma unroll
            for (int m = 0; m < 4; ++m) { const size_t off = (size_t)(row0 + ai * 128 + m * 16) * D + col0;
#pragma unroll
                for (int bj = 0; bj < 2; ++bj)
#pragma unroll
                    for (int n = 0; n < 2; ++n) { const size_t o2 = off + bj * 128 + n * 16; ga[m][bj][n] = *(const u32x2*)(gm + o2); gb[m][bj][n] = *(const u32x2*)(gc + o2); } }
#pragma unroll
            for (int m = 0; m < 4; ++m)
#pragma unroll
                for (int bj = 0; bj < 2; ++bj)
#pragma unroll
                    for (int n = 0; n < 2; ++n) { const u32x2 wa = ga[m][bj][n], wb = gb[m][bj][n]; f32x4 r;
                        r[0] = bflo(wa.x) * __builtin_amdgcn_rcpf(fmaxf(bflo(wb.x), 1e-30f)); r[1] = bfhi(wa.x) * __builtin_amdgcn_rcpf(fmaxf(bfhi(wb.x), 1e-30f));
                        r[2] = bflo(wa.y) * __builtin_amdgcn_rcpf(fmaxf(bflo(wb.y), 1e-30f)); r[3] = bfhi(wa.y) * __builtin_amdgcn_rcpf(fmaxf(bfhi(wb.y), 1e-30f));
                        acc[ai][bj][m][n] *= r; }
            asm volatile("" ::: "memory"); }
    }
    __device__ __forceinline__ void operator()(const f32x4 (&acc)[2][2][4][2], const Unit& u, int wr, int wc, int fr, int fq) const {
        const int row0 = u.pm * 256 + wr * 64 + fr, col0 = u.pn * 256 + wc * 32 + 4 * fq;
#pragma unroll
        for (int ai = 0; ai < 2; ++ai) { f32x4 gv[4][2][2];
#pragma unroll
            for (int m = 0; m < 4; ++m) { const size_t off = (size_t)(row0 + ai * 128 + m * 16) * D + col0;
#pragma unroll
                for (int bj = 0; bj < 2; ++bj)
#pragma unroll
                    for (int n = 0; n < 2; ++n) gv[m][bj][n] = ld4bf(gc + off + bj * 128 + n * 16); }
#pragma unroll
            for (int m = 0; m < 4; ++m) { const size_t off = (size_t)(row0 + ai * 128 + m * 16) * D + col0;
#pragma unroll
                for (int bj = 0; bj < 2; ++bj)
#pragma unroll
                    for (int n = 0; n < 2; ++n) { const size_t o2 = off + bj * 128 + n * 16; const f32x4 v = acc[ai][bj][m][n] * gv[m][bj][n]; u32x2 w; w.x = pk2(v[0], v[1]); w.y = pk2(v[2], v[3]); *(u32x2*)(z + o2) = w; } }
            asm volatile("" ::: "memory"); }
    }
};
template <int MODE> struct EpiResNorm {
    static constexpr bool PERM = false, AFTER_DRAIN = true, MIDK = false;
    const float* src; float* dst; const float* mod; int gidx; float* rowss; const XcdBarrier* xb; unsigned* panel;
    const float *ng, *shift, *scale; bf16_t* hx;
    __device__ __forceinline__ void fused(f32x4 (&acc)[2][2][4][2], const Unit& u, int wr, int wc, int fr, int fq, LAS unsigned char*, int, int) const {
        const int row0 = u.pm * 256 + wr * 64 + fr, col0 = u.pn * 256 + wc * 32 + 4 * fq, bidx = u.pm >> 3;
        const float* gt = mod + bidx * 6144 + gidx * 1024 + col0;
#pragma unroll
        for (int bj = 0; bj < 2; ++bj)
#pragma unroll
            for (int n = 0; n < 2; ++n) { const f32x4 gv = *(const f32x4*)(gt + bj * 128 + n * 16);
#pragma unroll
                for (int ai = 0; ai < 2; ++ai)
#pragma unroll
                    for (int m = 0; m < 4; ++m) acc[ai][bj][m][n] *= gv; }
#pragma unroll
        for (int ai = 0; ai < 2; ++ai)
#pragma unroll
            for (int m = 0; m < 4; ++m) { const int row = row0 + ai * 128 + m * 16; const size_t off = (size_t)row * D + col0; float ss = 0.f;
#pragma unroll
                for (int bj = 0; bj < 2; ++bj)
#pragma unroll
                    for (int n = 0; n < 2; ++n) { const f32x4 v = acc[ai][bj][m][n] + *(const f32x4*)(src + off + bj * 128 + n * 16); acc[ai][bj][m][n] = v; ss += (v[0] * v[0] + v[1] * v[1]) + (v[2] * v[2] + v[3] * v[3]); }
                ss += __shfl_xor(ss, 16); ss += __shfl_xor(ss, 32);
                if (fq == 0) (void)__hip_atomic_fetch_add(rowss + row, ss, __ATOMIC_RELAXED, __HIP_MEMORY_SCOPE_AGENT);
                asm volatile("" ::: "memory"); }
        asm volatile("s_waitcnt vmcnt(0)" ::: "memory");
        __syncthreads();
        if (threadIdx.x == 0) { unsigned* pc = panel + 16 * u.pm; (void)xb_add(pc, 1u); XB_SPIN(xb_ld(pc) < 4u, xb->bar); }
        __syncthreads();
        f32x4 gs[2][2], sh[2][2];
#pragma unroll
        for (int bj = 0; bj < 2; ++bj)
#pragma unroll
            for (int n = 0; n < 2; ++n) { const int c = col0 + bj * 128 + n * 16;
                if (MODE == 0) { gs[bj][n] = *(const f32x4*)(ng + c) * (*(const f32x4*)(scale + bidx * 6144 + c) + 1.0f); sh[bj][n] = *(const f32x4*)(shift + bidx * 6144 + c); }
                else { gs[bj][n] = *(const f32x4*)(ng + c); sh[bj][n] = (f32x4){0.f, 0.f, 0.f, 0.f}; } }
#pragma unroll
        for (int ai = 0; ai < 2; ++ai)
#pragma unroll
            for (int m = 0; m < 4; ++m) { const int row = row0 + ai * 128 + m * 16; const size_t off = (size_t)row * D + col0;
                const float rstd = rsqrtf(__hip_atomic_load(rowss + row, __ATOMIC_RELAXED, __HIP_MEMORY_SCOPE_AGENT) * (1.0f / D) + EPS);
#pragma unroll
                for (int bj = 0; bj < 2; ++bj)
#pragma unroll
                    for (int n = 0; n < 2; ++n) { const size_t o2 = off + bj * 128 + n * 16; const f32x4 v = acc[ai][bj][m][n]; const f32x4 y = v * rstd * gs[bj][n] + sh[bj][n];
                        if (MODE == 0) { *(f32x4*)(dst + o2) = v; u32x2 w; w.x = pk2(y[0], y[1]); w.y = pk2(y[2], y[3]); *(u32x2*)(hx + o2) = w; }
                        else *(f32x4*)(dst + o2) = y; }
                asm volatile("" ::: "memory"); }
    }
};
template <class Epi> __device__ __forceinline__ void run_gemm(LAS unsigned char* lds, const bf16_t* A, const bf16_t* Bt, int M, int N, int K, const Epi& E) {
    pg8::StaticOrder S; S.init(M, N, (int)gridDim.x, (int)blockIdx.x);
    pg8::Gemm g; g.A = A; g.Bt = Bt; g.M = M; g.N = N; g.K = K;
    pg8::gemm_phase<Epi, pg8::StaticOrder, !Epi::AFTER_DRAIN, true>(lds, g, S, E);
    __syncthreads();
}

__device__ __forceinline__ void phase2b(const Params& p) {
    const int gt = blockIdx.x * NT + otid(), ngrp = (gridDim.x * NT) >> 8;
    const int cc = gt & 255, isk = cc >> 7, col = (cc & 127) * 8;
    const bf16_t* src = (const bf16_t*)(p.ws + OFF_QKV) + (size_t)isk * ((size_t)TOK * D) + col;
    bf16_t* dst = (isk ? (bf16_t*)(p.ws + OFF_K) : (bf16_t*)p.out) + col;
    float w0[8], w1[8], w2[8], bb[8];
#pragma unroll
    for (int j = 0; j < 8; ++j) { const int wcn = isk * 1024 + col + j; w0[j] = p.qk_conv_w[wcn]; w1[j] = p.qk_conv_w[2048 + wcn]; w2[j] = p.qk_conv_w[4096 + wcn]; bb[j] = p.qk_conv_b[wcn]; }
    const float osc = isk ? 0.08838834764831845f : 1.0f;
    const int per = (TOK + ngrp - 1) / ngrp, nper = (per + 3) & ~3;
    const u32x4 zero = (u32x4){0u, 0u, 0u, 0u};
    for (int g = gt >> 8; g * nper < TOK; g += ngrp) {
        const int R0 = g * nper;
        u32x4 prev = R0 > 0 ? *(const u32x4*)(src + (size_t)(R0 - 1) * D) : zero, cur = *(const u32x4*)(src + (size_t)R0 * D);
        for (int i = 0; i < nper && R0 + i < TOK; i += 4) {
            u32x4 nx[4];
#pragma unroll
            for (int j = 0; j < 4; ++j) { const int Rn = R0 + i + j + 1; nx[j] = Rn < TOK ? *(const u32x4*)(src + (size_t)Rn * D) : zero; }
#pragma unroll
            for (int j = 0; j < 4; ++j) { const int R = R0 + i + j;
                if (R < TOK) {
                    int t, T; if (R < TOKC) { t = R & (CTXL - 1); T = CTXL; } else { t = (R - TOKC) & (SEQ - 1); T = SEQ; }
                    float f0[8], f1[8], f2[8], o[8]; unpack8(t > 0 ? prev : zero, f0); unpack8(cur, f1); unpack8(t < T - 1 ? nx[j] : zero, f2);
#pragma unroll
                    for (int e = 0; e < 8; ++e) { const float a = w0[e] * f0[e] + w1[e] * f1[e] + w2[e] * f2[e] + bb[e]; o[e] = a * sigmoidf_(a) * osc; }
                    *(u32x4*)(dst + (size_t)R * D) = pack8(o);
                }
                prev = cur; cur = nx[j]; }
        }
    }
}

__device__ __forceinline__ void phase5(const Params& p) {
    const int tid_ = otid(), lane = tid_ & 63, gw = blockIdx.x * 8 + (tid_ >> 6), ngw = gridDim.x * 8;
    const bf16_t* hf = (const bf16_t*)(p.ws + OFF_HF); const bf16_t* hb = (const bf16_t*)(p.ws + OFF_HB);
    bf16_t* ob = (bf16_t*)(p.ws + OFF_O); bf16_t* sbb = ob + D; const bf16_t* ub = (const bf16_t*)(p.ws + OFF_U);
    const int c0 = lane * 16;
    float mg[16], cw0[16], cw1[16], cw2[16], cbb[16];
#pragma unroll
    for (int j = 0; j < 16; ++j) { mg[j] = p.mnorm_g[c0 + j]; cw0[j] = p.sc_conv_w[c0 + j]; cw1[j] = p.sc_conv_w[1024 + c0 + j]; cw2[j] = p.sc_conv_w[2048 + c0 + j]; cbb[j] = p.sc_conv_b[c0 + j]; }
    const u32x4 zero = (u32x4){0u, 0u, 0u, 0u};
    for (int r0 = gw * 8; r0 < TOKL; r0 += ngw * 8) {
        u32x4 up[2], uc[2], un[2];
        { const int t0 = r0 & (SEQ - 1); const bf16_t* q = ub + (size_t)r0 * D + c0;
          up[0] = t0 > 0 ? *(const u32x4*)(q - D) : zero; up[1] = t0 > 0 ? *(const u32x4*)(q - D + 8) : zero; uc[0] = *(const u32x4*)q; uc[1] = *(const u32x4*)(q + 8); }
        u32x4 nx8[8];
        { const size_t off = (size_t)r0 * D + c0, off2 = (size_t)r0 * (2 * D) + c0;
          nx8[0] = *(const u32x4*)(hf + off); nx8[1] = *(const u32x4*)(hf + off + 8); nx8[2] = *(const u32x4*)(hb + off); nx8[3] = *(const u32x4*)(hb + off + 8);
          nx8[4] = *(const u32x4*)(ob + off2); nx8[5] = *(const u32x4*)(ob + off2 + 8); nx8[6] = *(const u32x4*)(sbb + off2); nx8[7] = *(const u32x4*)(sbb + off2 + 8); }
#pragma unroll
        for (int i = 0; i < 8; ++i) {
            const int row = r0 + i, t = row & (SEQ - 1);
            const size_t off = (size_t)row * D + c0, off2 = (size_t)row * (2 * D) + c0;
            const u32x4 hfa = nx8[0], hfb = nx8[1], hba = nx8[2], hbb = nx8[3], oa = nx8[4], obv = nx8[5], sa = nx8[6], sbv = nx8[7];
            if (i < 7) { const size_t offn = off + D, off2n = off2 + 2 * D;
              nx8[0] = *(const u32x4*)(hf + offn); nx8[1] = *(const u32x4*)(hf + offn + 8); nx8[2] = *(const u32x4*)(hb + offn); nx8[3] = *(const u32x4*)(hb + offn + 8);
              nx8[4] = *(const u32x4*)(ob + off2n); nx8[5] = *(const u32x4*)(ob + off2n + 8); nx8[6] = *(const u32x4*)(sbb + off2n); nx8[7] = *(const u32x4*)(sbb + off2n + 8); }
            un[0] = t < SEQ - 1 ? *(const u32x4*)(ub + off + D) : zero; un[1] = t < SEQ - 1 ? *(const u32x4*)(ub + off + D + 8) : zero;
            float h[16], so[16];
            { float a[8], b[8]; unpack8(hfa, a); unpack8(hba, b);
#pragma unroll
              for (int j = 0; j < 8; ++j) h[j] = a[j] + b[j];
              unpack8(hfb, a); unpack8(hbb, b);
#pragma unroll
              for (int j = 0; j < 8; ++j) h[8 + j] = a[j] + b[j];
              unpack8(oa, a);
#pragma unroll
              for (int j = 0; j < 8; ++j) so[j] = a[j];
              unpack8(obv, a);
#pragma unroll
              for (int j = 0; j < 8; ++j) so[8 + j] = a[j]; }
            float ss = 0.f;
#pragma unroll
            for (int j = 0; j < 16; ++j) ss += h[j] * h[j];
            ss += __shfl_xor(ss, 1); ss += __shfl_xor(ss, 2); ss += __shfl_xor(ss, 4);
            const float rstd = rsqrtf(ss * (1.0f / 128.0f) + EPS);
            { float a[8];
#pragma unroll
              for (int j = 0; j < 8; ++j) a[j] = h[j] * rstd * mg[j] * so[j];
              *(u32x4*)(ob + off2) = pack8(a);
#pragma unroll
              for (int j = 0; j < 8; ++j) a[j] = h[8 + j] * rstd * mg[8 + j] * so[8 + j];
              *(u32x4*)(ob + off2 + 8) = pack8(a); }
#pragma unroll
            for (int hv = 0; hv < 2; ++hv) {
                float u0[8], u1[8], u2[8], s[8], o[8];
                unpack8(t > 0 ? up[hv] : zero, u0); unpack8(uc[hv], u1); unpack8(un[hv], u2); unpack8(hv ? sbv : sa, s);
#pragma unroll
                for (int j = 0; j < 8; ++j) o[j] = s[j] * (cw0[hv * 8 + j] * u0[j] + cw1[hv * 8 + j] * u1[j] + cw2[hv * 8 + j] * u2[j] + cbb[hv * 8 + j]);
                *(u32x4*)(sbb + off2 + hv * 8) = pack8(o);
                up[hv] = uc[hv]; uc[hv] = un[hv];
            }
        }
    }
}

__device__ __forceinline__ void phase10(const Params& p) {
    const int tid = otid(); const bf16_t* A = (const bf16_t*)(p.ws + OFF_A); bf16_t* G = (bf16_t*)(p.ws + OFF_G);
    if (tid >= FF / 8) return;
    const int c0 = tid * 8;
    float wt[9][8], bb[8];
#pragma unroll
    for (int q = 0; q < 9; ++q)
#pragma unroll
        for (int j = 0; j < 8; ++j) wt[q][j] = p.ff_conv_w[q * FF + c0 + j];
#pragma unroll
    for (int j = 0; j < 8; ++j) bb[j] = p.ff_conv_b[c0 + j];
    const u32x4 zero = (u32x4){0u, 0u, 0u, 0u};
#define P10_COLSUM(col, n0, n1, n2) do { float f_[8]; unpack8((col)[0], f_); _Pragma("unroll") for (int e = 0; e < 8; ++e) { n0[e] = wt[0][e] * f_[e]; n1[e] = wt[1][e] * f_[e]; n2[e] = wt[2][e] * f_[e]; } \
        unpack8((col)[1], f_); _Pragma("unroll") for (int e = 0; e < 8; ++e) { n0[e] += wt[3][e] * f_[e]; n1[e] += wt[4][e] * f_[e]; n2[e] += wt[5][e] * f_[e]; } \
        unpack8((col)[2], f_); _Pragma("unroll") for (int e = 0; e < 8; ++e) { n0[e] += wt[6][e] * f_[e]; n1[e] += wt[7][e] * f_[e]; n2[e] += wt[8][e] * f_[e]; } } while (0)
    for (int it = blockIdx.x; it < 256; it += gridDim.x) {
        const int item = ((it & 7) << 5) | (it >> 3), b = item >> 5, r = item & 31;
        const size_t rowbase = ((size_t)b * SEQ + (size_t)r * 64) * FF + c0;
        const bool rv[3] = {r > 0, true, r < 31};
        float sA[8], sB1[8], sBc0[8];
        { u32x4 col0[3];
#pragma unroll
          for (int dr = 0; dr < 3; ++dr) col0[dr] = rv[dr] ? *(const u32x4*)(A + rowbase + (ptrdiff_t)(dr - 1) * 64 * FF) : zero;
          float n2[8]; P10_COLSUM(col0, sBc0, sB1, n2);
#pragma unroll
          for (int e = 0; e < 8; ++e) sA[e] = 0.f; }
        u32x4 cur[2][3], gq[2];
#pragma unroll
        for (int j = 0; j < 2; ++j) { gq[j] = *(const u32x4*)(G + rowbase + (size_t)j * FF);
#pragma unroll
            for (int dr = 0; dr < 3; ++dr) cur[j][dr] = rv[dr] ? *(const u32x4*)(A + rowbase + (ptrdiff_t)(dr - 1) * 64 * FF + (size_t)(1 + j) * FF) : zero; }
        for (int w = 0; w < 64; w += 2) {
            u32x4 nxt[2][3], gn[2];
#pragma unroll
            for (int j = 0; j < 2; ++j) { const int x = w + 3 + j;
                gn[j] = (w + 2 + j < 64) ? *(const u32x4*)(G + rowbase + (size_t)(w + 2 + j) * FF) : zero;
#pragma unroll
                for (int dr = 0; dr < 3; ++dr) nxt[j][dr] = (rv[dr] && x < 64) ? *(const u32x4*)(A + rowbase + (ptrdiff_t)(dr - 1) * 64 * FF + (size_t)x * FF) : zero; }
#pragma unroll
            for (int j = 0; j < 2; ++j) {
                float n0[8], n1[8], n2[8]; P10_COLSUM(cur[j], n0, n1, n2);
                float gg[8], o[8]; unpack8(gq[j], gg);
#pragma unroll
                for (int e = 0; e < 8; ++e) { const float a = sA[e] + sB1[e] + n2[e] + bb[e]; const float y2 = 1.5957691216057308f * (a + 0.044715f * a * a * a); o[e] = a * sigmoidf_(y2) * gg[e];
                    sA[e] = sBc0[e]; sB1[e] = n1[e]; sBc0[e] = n0[e]; }
                *(u32x4*)(G + rowbase + (size_t)(w + j) * FF) = pack8(o);
            }
#pragma unroll
            for (int j = 0; j < 2; ++j) { gq[j] = gn[j];
#pragma unroll
                for (int dr = 0; dr < 3; ++dr) cur[j][dr] = nxt[j][dr]; }
        }
    }
#undef P10_COLSUM
}
constexpr int QP = 272, VP = 224, CP = 272;
constexpr int L_Q = 0, L_K = 34816, L_V = 69632, L_VW = 98304, L_CB = 126976, L_GV = 148736, L_WK = 151808;
__device__ __forceinline__ bf16x8 tr8(LAS unsigned char* a0, LAS unsigned char* a1) {
    const bf16x4 lo = __builtin_amdgcn_ds_read_tr16_b64_v4i16((LAS bf16x4*)a0);
    const bf16x4 hi = __builtin_amdgcn_ds_read_tr16_b64_v4i16((LAS bf16x4*)a1);
    return __builtin_shufflevector(lo, hi, 0, 1, 2, 3, 4, 5, 6, 7);
}
__device__ __forceinline__ bf16x8 as_bf16x8(const u32x4 w) { union { u32x4 u; bf16x8 b; } c; c.u = w; return c.b; }
#define MFMA16(a, b, c) __builtin_amdgcn_mfma_f32_16x16x32_bf16((a), (b), (c), 0, 0, 0)
__device__ __forceinline__ void mlstm_load(int ci, int dir, int b, int h, int e0, int tid, int lane, int w, const bf16_t* Qg, const bf16_t* Kg, const bf16_t* Vg, const float* gates,
                                           u32x4 (&qreg)[4], u32x4 (&kreg)[4], u32x4 (&vreg)[2], float (&graw)[4]) {
    const bool emit = ci >= 2;
    const int cs = emit ? ci - 2 : ci, T = emit ? SEQ : CTXL, rbase = emit ? TOKC + b * SEQ : b * CTXL;
    const int tb = dir ? T - 1 - cs * 128 : cs * 128, ts = dir ? -1 : 1;
#pragma unroll
    for (int i = 0; i < 4; ++i) { const int n = tid + NT * i, j = n >> 4, ch = n & 15; const size_t ro = (size_t)(rbase + tb + ts * j) * D + h * 128 + ch * 8;
        kreg[i] = *(const u32x4*)(Kg + ro); if (emit) qreg[i] = *(const u32x4*)(Qg + ro); }
#pragma unroll
    for (int i = 0; i < 2; ++i) { const int n = tid + NT * i, j = n >> 3, ch = n & 7; vreg[i] = *(const u32x4*)(Vg + (size_t)(rbase + tb + ts * j) * D + h * 128 + e0 + ch * 8); }
    if (w == 0) { const int j0 = 2 * lane; const size_t r0 = (size_t)(rbase + tb + ts * j0) * 32 + dir * 16 + h, r1 = (size_t)(rbase + tb + ts * (j0 + 1)) * 32 + dir * 16 + h;
        graw[0] = gates[r0]; graw[1] = gates[r0 + 8]; graw[2] = gates[r1]; graw[3] = gates[r1 + 8]; }
}
__device__ __forceinline__ void mlstm_gates(int lane, const float (&graw)[4], float mst, LAS float* gvS, LAS float* MS, LAS float* bS) {
    const int j0 = 2 * lane;
    const float ig0 = graw[0], f0 = graw[1], ig1 = graw[2], f1 = graw[3];
    const float lf0 = fminf(f0, 0.f) - log1pf(expf(-fabsf(f0))), lf1 = fminf(f1, 0.f) - log1pf(expf(-fabsf(f1)));
    float s = lf0 + lf1;
#pragma unroll
    for (int o = 1; o < 64; o <<= 1) { const float t = __shfl_up(s, o); if (lane >= o) s += t; }
    const float b0 = s - lf1, b1 = s;
    const float gv0 = ig0 - b0, gv1 = ig1 - b1;
    float mx = fmaxf(gv0, gv1);
#pragma unroll
    for (int o = 1; o < 64; o <<= 1) { const float t = __shfl_up(mx, o); if (lane >= o) mx = fmaxf(mx, t); }
    float pe = __shfl_up(mx, 1); if (lane == 0) pe = -3.0e38f;
    const float pm0 = fmaxf(pe, gv0), pm1 = mx;
    gvS[j0] = gv0; gvS[j0 + 1] = gv1; MS[j0] = fmaxf(mst, pm0); MS[j0 + 1] = fmaxf(mst, pm1); bS[j0] = b0; bS[j0 + 1] = b1;
}
__device__ __forceinline__ void phase3(const Params& p, LAS unsigned char* lds) {
    const int tid = otid(), lane = tid & 63, w = __builtin_amdgcn_readfirstlane(tid >> 6), g = lane >> 4, l15 = lane & 15, q4 = l15 >> 2, p4 = l15 & 3;
    const int itile = w < 4 ? w : 11 - w;
    const bf16_t* Qg = (const bf16_t*)p.out; const bf16_t* Kg = (const bf16_t*)(p.ws + OFF_K); const bf16_t* Vg = (const bf16_t*)(p.ws + OFF_V);
    const float* gates = (const float*)(p.ws + OFF_GATES);
    LAS unsigned char* Qs = lds + L_Q; LAS unsigned char* Ks = lds + L_K; LAS unsigned char* Vs = lds + L_V; LAS unsigned char* VWs = lds + L_VW; LAS unsigned char* Cbs = lds + L_CB;
    LAS float* gvS0 = (LAS float*)(lds + L_GV);
    const f32x4 zero4 = (f32x4){0.f, 0.f, 0.f, 0.f};
    for (int blk = blockIdx.x; blk < 256; blk += gridDim.x) {
        const int xcd = blk & 7, slot = blk >> 3, grp = xcd * 8 + (slot >> 2), sub = slot & 3, dir = sub >> 1, eh = sub & 1, b = grp >> 3, h = grp & 7, e0 = eh * 64;
        bf16_t* Hout = (bf16_t*)(p.ws + (dir ? OFF_HB : OFF_HF));
        f32x4 Cacc[5];
#pragma unroll
        for (int c = 0; c < 5; ++c) Cacc[c] = zero4;
        float mst = -1e30f;
        for (int i = tid; i < 80 * CP / 4; i += NT) ((LAS unsigned*)Cbs)[i] = 0u;
        __syncthreads();
        u32x4 qreg[4], kreg[4], vreg[2]; float graw[4];
        mlstm_load(0, dir, b, h, e0, tid, lane, w, Qg, Kg, Vg, gates, qreg, kreg, vreg, graw);
        if (w == 0) mlstm_gates(lane, graw, mst, gvS0, gvS0 + 128, gvS0 + 256);
        __syncthreads();
        for (int ci = 0; ci < 18; ++ci) {
            const bool emit = ci >= 2;
            const int cs = emit ? ci - 2 : ci, T = emit ? SEQ : CTXL, rbase = emit ? TOKC + b * SEQ : b * CTXL;
            const int tb = dir ? T - 1 - cs * 128 : cs * 128, ts = dir ? -1 : 1;
            LAS float* gvS = gvS0 + (ci & 1) * 384; LAS float* MS = gvS + 128; LAS float* bS = gvS + 256; LAS float* gvN = gvS0 + ((ci + 1) & 1) * 384;
            const float M127 = MS[127], bend = bS[127];
            const float decay = __expf(mst - M127);
#pragma unroll
            for (int i = 0; i < 4; ++i) { const int n = tid + NT * i, j = n >> 4, ch = n & 15; *(LAS u32x4*)(Ks + j * QP + ch * 16) = kreg[i]; if (emit) *(LAS u32x4*)(Qs + j * QP + ch * 16) = qreg[i]; }
#pragma unroll
            for (int i = 0; i < 2; ++i) { const int n = tid + NT * i, j = n >> 3, ch = n & 7;
                const float wk = __expf(gvS[j] - M127); float f[8]; unpack8(vreg[i], f);
#pragma unroll
                for (int e = 0; e < 8; ++e) f[e] *= wk;
                *(LAS u32x4*)(VWs + j * VP + ch * 16) = pack8(f); }
            if (tid < 128) { const float wk = __expf(gvS[tid] - M127); *(LAS u32x4*)(VWs + tid * VP + 128) = (u32x4){pk2(wk, 0.f), 0u, 0u, 0u}; *(LAS u32x4*)(VWs + tid * VP + 144) = (u32x4){0u, 0u, 0u, 0u}; }
            if (ci + 1 < 18) mlstm_load(ci + 1, dir, b, h, e0, tid, lane, w, Qg, Kg, Vg, gates, qreg, kreg, vreg, graw);
            __syncthreads();
            if (emit) {
                bf16x8 qf[4];
#pragma unroll
                for (int ks = 0; ks < 4; ++ks) qf[ks] = *(const LAS bf16x8*)(Qs + (16 * itile + l15) * QP + (32 * ks + 8 * g) * 2);
                f32x4 oacc[5];
#pragma unroll
                for (int c = 0; c < 5; ++c) oacc[c] = zero4;
#pragma unroll
                for (int ks = 0; ks < 4; ++ks) { bf16x8 cb[5];
#pragma unroll
                    for (int c = 0; c < 5; ++c) cb[c] = *(const LAS bf16x8*)(Cbs + (16 * c + l15) * CP + (32 * ks + 8 * g) * 2);
                    __builtin_amdgcn_sched_barrier(0);
#pragma unroll
                    for (int c = 0; c < 5; ++c) oacc[c] = MFMA16(qf[ks], cb[c], oacc[c]);
                    __builtin_amdgcn_sched_barrier(0); }
#pragma unroll
                for (int c = 0; c < 5; ++c) oacc[c] *= decay;
                const int iq = 16 * itile + l15;
#pragma unroll
                for (int s = 0; s < 4; ++s) if (s <= (itile >> 1)) {
                    const int jt0 = 2 * s, jt1 = 2 * s + 1;
                    f32x4 st0 = zero4, st1 = zero4;
                    bf16x8 kf0[4], kf1[4], vb[5];
#pragma unroll
                    for (int ks = 0; ks < 4; ++ks) { kf0[ks] = *(const LAS bf16x8*)(Ks + (16 * jt0 + l15) * QP + (32 * ks + 8 * g) * 2); kf1[ks] = *(const LAS bf16x8*)(Ks + (16 * jt1 + l15) * QP + (32 * ks + 8 * g) * 2); }
#pragma unroll
                    for (int c = 0; c < 5; ++c) vb[c] = tr8(VWs + (32 * s + 4 * g + q4) * VP + (16 * c + 4 * p4) * 2, VWs + (32 * s + 16 + 4 * g + q4) * VP + (16 * c + 4 * p4) * 2);
                    __builtin_amdgcn_sched_barrier(0);
#pragma unroll
                    for (int ks = 0; ks < 4; ++ks) { st0 = MFMA16(kf0[ks], qf[ks], st0); st1 = MFMA16(kf1[ks], qf[ks], st1); }
                    __builtin_amdgcn_sched_barrier(0);
#pragma unroll
                    for (int r = 0; r < 4; ++r) { const int ja = 16 * jt0 + 4 * g + r, jb = 16 * jt1 + 4 * g + r;
                        st0[r] = (ja <= iq) ? st0[r] : 0.f; st1[r] = (jb <= iq) ? st1[r] : 0.f; }
                    u32x4 pw; pw.x = pk2(st0[0], st0[1]); pw.y = pk2(st0[2], st0[3]); pw.z = pk2(st1[0], st1[1]); pw.w = pk2(st1[2], st1[3]);
                    const bf16x8 pa = as_bf16x8(pw);
#pragma unroll
                    for (int c = 0; c < 5; ++c) oacc[c] = MFMA16(pa, vb[c], oacc[c]);
                    __builtin_amdgcn_sched_barrier(0);
                }
                { const f32x4 bi = *(const LAS f32x4*)(bS + 16 * itile + 4 * g);
#pragma unroll
                  for (int r = 0; r < 4; ++r) { const float den = __shfl(oacc[4][r], lane & 48); const float inv = 1.0f / fmaxf(fabsf(den), __expf(-(bi[r] + M127)));
                      const int ir = 16 * itile + 4 * g + r; bf16_t* hp = Hout + (size_t)(b * SEQ + tb + ts * ir) * D + h * 128 + e0 + l15;
#pragma unroll
                      for (int c = 0; c < 4; ++c) hp[16 * c] = (bf16_t)(pk2(oacc[c][r] * inv, 0.f) & 0xffffu); } }
            }
#pragma unroll
            for (int c = 0; c < 5; ++c) Cacc[c] *= decay;
#pragma unroll
            for (int ks = 0; ks < 4; ++ks) { bf16x8 vw[5];
                const bf16x8 ka = tr8(Ks + (32 * ks + 4 * g + q4) * QP + (16 * w + 4 * p4) * 2, Ks + (32 * ks + 16 + 4 * g + q4) * QP + (16 * w + 4 * p4) * 2);
#pragma unroll
                for (int c = 0; c < 5; ++c) vw[c] = tr8(VWs + (32 * ks + 4 * g + q4) * VP + (16 * c + 4 * p4) * 2, VWs + (32 * ks + 16 + 4 * g + q4) * VP + (16 * c + 4 * p4) * 2);
                __builtin_amdgcn_sched_barrier(0);
#pragma unroll
                for (int c = 0; c < 5; ++c) Cacc[c] = MFMA16(ka, vw[c], Cacc[c]);
                __builtin_amdgcn_sched_barrier(0); }
            mst = bend + M127;
            if (w == 0 && ci + 1 < 18) mlstm_gates(lane, graw, mst, gvN, gvN + 128, gvN + 256);
            __syncthreads();
#pragma unroll
            for (int c = 0; c < 5; ++c) { u32x2 cw; cw.x = pk2(Cacc[c][0], Cacc[c][1]); cw.y = pk2(Cacc[c][2], Cacc[c][3]); *(LAS u32x2*)(Cbs + (16 * c + l15) * CP + (16 * w + 4 * g) * 2) = cw; }
        }
        __syncthreads();
    }
}
constexpr int NPHASE = 15;
template <int PH> __device__ __forceinline__ void run_phase(const Params& p, LAS unsigned char* lds, const XcdBarrier* xbp) {
    unsigned char* ws = p.ws;
    if constexpr (PH == 0) phase0(p, lds);
    if constexpr (PH == 1) phase1(p);
    if constexpr (PH == 2) { Epi1a E; E.qkv = (bf16_t*)(ws + OFF_QKV); E.gates = (float*)(ws + OFF_GATES); E.gate_b = p.gate_b;
        run_gemm(lds, (const bf16_t*)(ws + OFF_AH), (const bf16_t*)(ws + OFF_WIN), TOK, N1A, D, E); }
    if constexpr (PH == 3) phase2b(p);
    if constexpr (PH == 4) phase3(p, lds);
    if constexpr (PH == 5) { Epi1b E; E.osb = (bf16_t*)(ws + OFF_O); E.uu = (bf16_t*)(ws + OFF_U); E.gmc = (bf16_t*)p.out;
        run_gemm(lds, (const bf16_t*)(ws + OFF_AH) + (size_t)TOKC * D, (const bf16_t*)(ws + OFF_WIN) + (size_t)N1A * D, TOKL, N1B, D, E); }
    if constexpr (PH == 6) phase5(p);
    if constexpr (PH == 7) { EpiMerge2 E; E.gm = (const bf16_t*)p.out; E.gc = (const bf16_t*)p.out + (size_t)TOKL * D; E.z = (bf16_t*)(ws + OFF_Z);
        run_gemm(lds, (const bf16_t*)(ws + OFF_O), (const bf16_t*)(ws + OFF_WM), TOKL, D, 2 * D, E); }
    if constexpr (PH == 9) { EpiResNorm<0> E; E.src = p.x; E.dst = p.out; E.mod = (const float*)(ws + OFF_MOD); E.gidx = 2; E.rowss = (float*)(ws + OFF_RS); E.xb = xbp; E.panel = (unsigned*)(ws + OFF_HCTR + 1024);
        E.ng = p.norm2_g; E.shift = (const float*)(ws + OFF_MOD) + 3 * 1024; E.scale = (const float*)(ws + OFF_MOD) + 4 * 1024; E.hx = (bf16_t*)(ws + OFF_HX2);
        run_gemm(lds, (const bf16_t*)(ws + OFF_Z), (const bf16_t*)(ws + OFF_WO), TOKL, D, D, E); }
    if constexpr (PH == 11) { EpiUp E; E.a = (bf16_t*)(ws + OFF_A); E.g = (bf16_t*)(ws + OFF_G);
        run_gemm(lds, (const bf16_t*)(ws + OFF_HX2), (const bf16_t*)(ws + OFF_WUP), TOKL, 2 * FF, D, E); }
    if constexpr (PH == 12) phase10(p);
    if constexpr (PH == 13) { EpiResNorm<1> E; E.src = p.out; E.dst = p.out; E.mod = (const float*)(ws + OFF_MOD); E.gidx = 5; E.rowss = (float*)(ws + OFF_RS) + TOKL; E.xb = xbp; E.panel = (unsigned*)(ws + OFF_HCTR + 1024 + 4096);
        E.ng = p.final_g; E.shift = nullptr; E.scale = nullptr; E.hx = nullptr;
        run_gemm(lds, (const bf16_t*)(ws + OFF_G), (const bf16_t*)(ws + OFF_WDN), TOKL, D, FF, E); }
}
template <int PH> __device__ __forceinline__ void run_all(const Params& p, LAS unsigned char* lds, cg::grid_group& grid, const XcdBarrier& xb) {
    run_phase<PH>(p, lds, &xb);
    if constexpr (PH == 0) {
        if (threadIdx.x == 0) XB_SPIN(xb_ld((unsigned*)(p.ws + OFF_HCTR)) < 192u, xb.bar);
        __syncthreads();
        __builtin_amdgcn_fence(__ATOMIC_ACQUIRE, "agent");
    }
    if constexpr (PH == 4) xcd_barrier_nofence(xb);
    if constexpr (PH + 1 < NPHASE) { if constexpr (PH != 0 && PH != 4 && PH != 8 && PH != 10 && PH != 13) xcd_barrier(xb);
        run_all<PH + 1>(p, lds, grid, xb); }
}
__global__ __launch_bounds__(NT) void k_mega(Params p) {
    extern __shared__ __attribute__((aligned(16))) unsigned char shm[];
    cg::grid_group grid = cg::this_grid();
    volatile LAS unsigned* st = (volatile LAS unsigned*)((LAS unsigned char*)shm + LDS_BYTES - 16);
    if (threadIdx.x < 4) st[threadIdx.x] = 0u;
    __syncthreads();
    const XcdBarrier xb = xcd_barrier_post((unsigned*)(p.ws + OFF_BAR), st);
    if (p.ws == nullptr) grid.sync();
    run_all<0>(p, (LAS unsigned char*)shm, grid, xb);
}

extern "C" void kernel_launch(void* const* d_in, const int* in_sizes, int n_in, void* d_out, int out_size, void* d_ws, size_t ws_size, hipStream_t stream) {
    static int grid = 0;
    if (grid == 0) {
        if (n_in != 23 || in_sizes[0] != TOKL * D || out_size != TOKL * D || ws_size < WS_NEED) {
            fprintf(stderr, "kernel_launch: unexpected shapes (n_in %d, in0 %d, out %d, ws %zu); nothing launched\n", n_in, n_in > 0 ? in_sizes[0] : -1, out_size, ws_size); grid = -1; return; }
        int dev = 0, cus = 0, per_cu = 0;
        hipGetDevice(&dev); hipDeviceGetAttribute(&cus, hipDeviceAttributeMultiprocessorCount, dev);
        if (hipFuncSetAttribute((const void*)k_mega, hipFuncAttributeMaxDynamicSharedMemorySize, LDS_BYTES) != hipSuccess) { fprintf(stderr, "kernel_launch: hipFuncSetAttribute failed\n"); grid = -1; return; }
        if (hipOccupancyMaxActiveBlocksPerMultiprocessor(&per_cu, (const void*)k_mega, NT, LDS_BYTES) != hipSuccess || per_cu < 1) { fprintf(stderr, "kernel_launch: occupancy query gave %d blocks per CU\n", per_cu); (void)hipGetLastError(); per_cu = 1; }
        grid = cus;
        if (grid != 256) fprintf(stderr, "kernel_launch: built for 256 CUs (the fused-norm GEMM epilogues need exactly one 256x256 unit per workgroup); got %d\n", grid);
    }
    if (grid < 0) return;
    Params p{};
    const float** f = (const float**)&p;
    for (int i = 0; i < 23; ++i) f[i] = (const float*)d_in[i];
    p.out = (float*)d_out; p.ws = (unsigned char*)d_ws;
    if (hipMemsetAsync((char*)d_ws + OFF_MOD, 0, (OFF_BAR - OFF_MOD) + ZERO_BYTES, stream) != hipSuccess) { fprintf(stderr, "kernel_launch: memset of the barrier words failed\n"); return; }
    void* args[] = {&p};
    hipError_t e = hipLaunchCooperativeKernel((const void*)k_mega, dim3(grid), dim3(NT), args, LDS_BYTES, stream);
    if (e != hipSuccess) fprintf(stderr, "cooperative launch failed: %s (grid %d)\n", hipGetErrorString(e), grid);
}
```
